# Optimizing an MI355X kernel written in HIP

```python
import jax, jax.numpy as jnp
from jax import lax
import numpy as np

D_MODEL = 2048
BATCH = 4
SEQ = 2048
DEPTH = 1
DEC_BATCH = 128
DEC_SEQ = 4
PAST_LEN = 16384
PAGE_SIZE = 128

N_HEADS_A = 4
DK_A = 256
DV_A = 512
QK_A = N_HEADS_A * DK_A
V_A = N_HEADS_A * DV_A
CONV_W = 4
MLSTM_CHUNK = 64
N_GROUPS_B = 4
D_B = 2048
GMLP_CHUNK = 128
D_FF = 5632
D_PLE = 256
EPS = 1e-6
D_IN = 2 * QK_A + 2 * V_A + 2 * N_HEADS_A + 2 * D_B + 2 * D_MODEL

kernel_name = 'hybrid_mlstm_gmlp_decoder_step'


def _rms(x, g):
    xf = x.astype(jnp.float32)
    y = xf * lax.rsqrt(jnp.mean(xf * xf, axis=-1, keepdims=True) + EPS)
    return (y * g.astype(jnp.float32)).astype(x.dtype)


def _layer_norm(x, g, b):
    xf = x.astype(jnp.float32)
    mu = jnp.mean(xf, axis=-1, keepdims=True)
    var = jnp.mean(jnp.square(xf - mu), axis=-1, keepdims=True)
    y = (xf - mu) * lax.rsqrt(var + EPS) * g.astype(jnp.float32) + b.astype(jnp.float32)
    return y.astype(x.dtype)


def _swiglu(x, wg, wu, wd):
    return (jax.nn.silu(x @ wg) * (x @ wu)) @ wd


def _causal_conv(x, buf, w, b):
    S = x.shape[1]
    xp = jnp.concatenate([buf.astype(x.dtype), x], axis=1)
    y = b
    for j in range(CONV_W):
        y = y + xp[:, j:j + S] * w[j]
    return y, xp[:, S:]


def _mlstm(q, k, v, ig, lf, C0, n0, m0):
    B, S, H, _ = q.shape
    L = min(S, MLSTM_CHUNK)
    nc = S // L

    def to_chunks(a):
        return jnp.moveaxis(a.reshape((B, nc, L) + a.shape[2:]), 1, 0)

    xs = (to_chunks(q), to_chunks(k), to_chunks(v), to_chunks(ig), to_chunks(lf))
    mask = jnp.tril(jnp.ones((L, L), dtype=bool))

    def step(carry, inp):
        C, n, m = carry
        qc, kc, vc, ic, fc = inp
        qc = qc.transpose(0, 2, 1, 3)
        kc = kc.transpose(0, 2, 1, 3)
        vc = vc.transpose(0, 2, 1, 3)
        ic = ic.transpose(0, 2, 1)
        bcum = jnp.cumsum(fc.transpose(0, 2, 1), axis=-1)
        d = jnp.where(mask, bcum[..., :, None] - bcum[..., None, :] + ic[..., None, :], -jnp.inf)
        m_in = bcum + m[..., None]
        m_t = jnp.maximum(m_in, jnp.max(d, axis=-1))
        s = jnp.einsum('bhtd,bhsd->bhts', qc, kc) * jnp.exp(d - m_t[..., None])
        w_prev = jnp.exp(m_in - m_t)
        num = jnp.einsum('bhts,bhsv->bhtv', s, vc) + w_prev[..., None] * jnp.einsum('bhtd,bhdv->bhtv', qc, C)
        den = jnp.sum(s, axis=-1) + w_prev * jnp.einsum('bhtd,bhd->bht', qc, n)
        h = num / jnp.maximum(jnp.abs(den), jnp.exp(-m_t))[..., None]
        m_new = m_t[..., -1]
        w_end = jnp.exp(bcum[..., -1:] - bcum + ic - m_new[..., None])
        decay = jnp.exp(bcum[..., -1] + m - m_new)
        C_new = decay[..., None, None] * C + jnp.einsum('bhs,bhsd,bhsv->bhdv', w_end, kc, vc)
        n_new = decay[..., None] * n + jnp.einsum('bhs,bhsd->bhd', w_end, kc)
        return (C_new, n_new, m_new), h

    (C, n, m), hs = lax.scan(step, (C0, n0, m0), xs)
    h = jnp.moveaxis(hs, 0, 1).transpose(0, 1, 3, 2, 4).reshape(B, S, H, -1)
    return h, C, n, m


def _spatial_gate(v, w_s, b_s):
    B, S, _ = v.shape
    L = min(S, GMLP_CHUNK)
    vc = v.reshape(B, S // L, L, N_GROUPS_B, D_B // N_GROUPS_B)
    w = jnp.where(jnp.tril(jnp.ones((L, L), dtype=bool)), w_s[:, :L, :L], 0.0).astype(v.dtype)
    out = jnp.einsum('gts,bnsgc->bntgc', w, vc) + b_s[:, :L].T[None, None, :, :, None].astype(v.dtype)
    return out.reshape(B, S, D_B)


def _layer(x, p, conv_buf, C0, n0, m0, lw):
    B, S, _ = x.shape
    f32 = jnp.float32
    h = x + 0.5 * _rms(_swiglu(_rms(x, lw['g_ffn1_pre']), lw['w_ffn1_gate'], lw['w_ffn1_up'], lw['w_ffn1_down']), lw['g_ffn1_post'])
    xn = _rms(h, lw['g_mix_pre'])
    z = xn @ lw['w_in']
    sizes = [2 * QK_A, V_A, V_A, N_HEADS_A, N_HEADS_A, D_B, D_B, D_MODEL, D_MODEL]
    qk_pre, v_a, o_a, i_pre, f_pre, u_b, v_b, gate_a, gate_b = jnp.split(z, [int(c) for c in np.cumsum(sizes)[:-1]], axis=-1)
    qk, new_buf = _causal_conv(qk_pre, conv_buf, lw['w_conv'], lw['b_conv'])
    qk = jax.nn.silu(qk).astype(f32)
    q = qk[..., :QK_A].reshape(B, S, N_HEADS_A, DK_A)
    k = qk[..., QK_A:].reshape(B, S, N_HEADS_A, DK_A) * (DK_A ** -0.5)
    v = v_a.astype(f32).reshape(B, S, N_HEADS_A, DV_A)
    ig = i_pre.astype(f32) + lw['b_igate'].astype(f32)
    lf = jax.nn.log_sigmoid(f_pre.astype(f32) + lw['b_fgate'].astype(f32))
    h_a, C, n, m = _mlstm(q, k, v, ig, lf, C0.astype(f32), n0.astype(f32), m0.astype(f32))
    h_a = h_a * lax.rsqrt(jnp.mean(h_a * h_a, axis=-1, keepdims=True) + EPS) * lw['g_head'].astype(f32).reshape(N_HEADS_A, DV_A)
    h_a = (jax.nn.sigmoid(o_a.astype(f32)) * h_a.reshape(B, S, V_A)).astype(x.dtype)
    y_a = h_a @ lw['w_a_out']
    u = jax.nn.gelu(u_b, approximate=False)
    vg = _layer_norm(jax.nn.gelu(v_b, approximate=False), lw['g_ln_v'], lw['b_ln_v'])
    y_b = (u * _spatial_gate(vg, lw['w_spatial'], lw['b_spatial'])) @ lw['w_b_out']
    mix = (jax.nn.sigmoid(gate_a) * y_a + jax.nn.sigmoid(gate_b) * y_b) @ lw['w_o']
    h = h + _rms(mix, lw['g_mix_post'])
    h = h + 0.5 * _rms(_swiglu(_rms(h, lw['g_ffn2_pre']), lw['w_ffn2_gate'], lw['w_ffn2_up'], lw['w_ffn2_down']), lw['g_ffn2_post'])
    e = jax.nn.sigmoid(_rms(h, lw['g_ple_pre']) @ lw['w_ple_gate']) * (p @ lw['w_ple_up'])
    h = h + _rms(e, lw['g_ple_post'])
    return h, new_buf, C, n, m, vg


def setup_inputs(seed: int = 0) -> dict:
    key = jax.random.key(seed)
    ks = list(jax.random.split(key, 48))

    def nrm(shape, scale):
        return jax.random.normal(ks.pop(), shape, jnp.float32) * scale

    def gain(width):
        return 1.0 + nrm((DEPTH, width), 0.05)

    return {
        'x_prompt': nrm((BATCH, SEQ, D_MODEL), 1.0),
        'x_sample': nrm((DEC_BATCH, DEC_SEQ, D_MODEL), 1.0),
        'p_prompt': nrm((DEPTH, BATCH, SEQ, D_PLE), 1.0),
        'p_sample': nrm((DEPTH, DEC_BATCH, DEC_SEQ, D_PLE), 1.0),
        'state_mlstm_conv': nrm((DEPTH, DEC_BATCH, CONV_W - 1, 2 * QK_A), 1.0),
        'state_mlstm_C': nrm((DEPTH, DEC_BATCH, N_HEADS_A, DK_A, DV_A), 0.02),
        'state_mlstm_n': nrm((DEPTH, DEC_BATCH, N_HEADS_A, DK_A), 0.1),
        'state_mlstm_m': nrm((DEPTH, DEC_BATCH, N_HEADS_A), 1.0),
        'g_ffn1_pre': gain(D_MODEL),
        'w_ffn1_gate': nrm((DEPTH, D_MODEL, D_FF), D_MODEL ** -0.5),
        'w_ffn1_up': nrm((DEPTH, D_MODEL, D_FF), D_MODEL ** -0.5),
        'w_ffn1_down': nrm((DEPTH, D_FF, D_MODEL), D_FF ** -0.5),
        'g_ffn1_post': gain(D_MODEL),
        'g_mix_pre': gain(D_MODEL),
        'w_in': nrm((DEPTH, D_MODEL, D_IN), D_MODEL ** -0.5),
        'w_conv': nrm((DEPTH, CONV_W, 2 * QK_A), CONV_W ** -0.5),
        'b_conv': nrm((DEPTH, 2 * QK_A), 0.02),
        'b_igate': nrm((DEPTH, N_HEADS_A), 0.1),
        'b_fgate': 3.0 + nrm((DEPTH, N_HEADS_A), 0.5),
        'g_head': gain(V_A),
        'w_a_out': nrm((DEPTH, V_A, D_MODEL), V_A ** -0.5),
        'g_ln_v': gain(D_B),
        'b_ln_v': nrm((DEPTH, D_B), 0.02),
        'w_spatial': nrm((DEPTH, N_GROUPS_B, GMLP_CHUNK, GMLP_CHUNK), GMLP_CHUNK ** -0.5),
        'b_spatial': 1.0 + nrm((DEPTH, N_GROUPS_B, GMLP_CHUNK), 0.05),
        'w_b_out': nrm((DEPTH, D_B, D_MODEL), D_B ** -0.5),
        'w_o': nrm((DEPTH, D_MODEL, D_MODEL), D_MODEL ** -0.5),
        'g_mix_post': gain(D_MODEL),
        'g_ffn2_pre': gain(D_MODEL),
        'w_ffn2_gate': nrm((DEPTH, D_MODEL, D_FF), D_MODEL ** -0.5),
        'w_ffn2_up': nrm((DEPTH, D_MODEL, D_FF), D_MODEL ** -0.5),
        'w_ffn2_down': nrm((DEPTH, D_FF, D_MODEL), D_FF ** -0.5),
        'g_ffn2_post': gain(D_MODEL),
        'g_ple_pre': gain(D_MODEL),
        'w_ple_gate': nrm((DEPTH, D_MODEL, D_MODEL), D_MODEL ** -0.5),
        'w_ple_up': nrm((DEPTH, D_PLE, D_MODEL), D_PLE ** -0.5),
        'g_ple_post': gain(D_MODEL),
    }


def reference(x_prompt, x_sample, p_prompt, p_sample, state_mlstm_conv, state_mlstm_C, state_mlstm_n, state_mlstm_m,
              g_ffn1_pre, w_ffn1_gate, w_ffn1_up, w_ffn1_down, g_ffn1_post,
              g_mix_pre, w_in, w_conv, b_conv, b_igate, b_fgate, g_head, w_a_out,
              g_ln_v, b_ln_v, w_spatial, b_spatial, w_b_out, w_o, g_mix_post,
              g_ffn2_pre, w_ffn2_gate, w_ffn2_up, w_ffn2_down, g_ffn2_post,
              g_ple_pre, w_ple_gate, w_ple_up, g_ple_post):
    hp, hs = x_prompt, x_sample
    conv_p, C_p, n_p, m_p = [], [], [], []
    conv_s, C_s, n_s, m_s, v_s = [], [], [], [], []
    for i in range(DEPTH):
        lw = dict(g_ffn1_pre=g_ffn1_pre[i], w_ffn1_gate=w_ffn1_gate[i], w_ffn1_up=w_ffn1_up[i], w_ffn1_down=w_ffn1_down[i],
                  g_ffn1_post=g_ffn1_post[i], g_mix_pre=g_mix_pre[i], w_in=w_in[i], w_conv=w_conv[i], b_conv=b_conv[i],
                  b_igate=b_igate[i], b_fgate=b_fgate[i], g_head=g_head[i], w_a_out=w_a_out[i], g_ln_v=g_ln_v[i],
                  b_ln_v=b_ln_v[i], w_spatial=w_spatial[i], b_spatial=b_spatial[i], w_b_out=w_b_out[i], w_o=w_o[i],
                  g_mix_post=g_mix_post[i], g_ffn2_pre=g_ffn2_pre[i], w_ffn2_gate=w_ffn2_gate[i], w_ffn2_up=w_ffn2_up[i],
                  w_ffn2_down=w_ffn2_down[i], g_ffn2_post=g_ffn2_post[i], g_ple_pre=g_ple_pre[i],
                  w_ple_gate=w_ple_gate[i], w_ple_up=w_ple_up[i], g_ple_post=g_ple_post[i])
        buf0 = jnp.zeros((hp.shape[0], CONV_W - 1, 2 * QK_A), hp.dtype)
        C0 = jnp.zeros((hp.shape[0], N_HEADS_A, DK_A, DV_A), jnp.float32)
        n0 = jnp.zeros((hp.shape[0], N_HEADS_A, DK_A), jnp.float32)
        m0 = jnp.zeros((hp.shape[0], N_HEADS_A), jnp.float32)
        hp, bp, cp, np_, mp, _ = _layer(hp, p_prompt[i], buf0, C0, n0, m0, lw)
        conv_p.append(bp); C_p.append(cp); n_p.append(np_); m_p.append(mp)
        hs, bs, cs, ns, ms, vs = _layer(hs, p_sample[i], state_mlstm_conv[i], state_mlstm_C[i], state_mlstm_n[i], state_mlstm_m[i], lw)
        conv_s.append(bs); C_s.append(cs); n_s.append(ns); m_s.append(ms); v_s.append(vs)
    return (hp, hs, jnp.stack(conv_p), jnp.stack(C_p), jnp.stack(n_p), jnp.stack(m_p),
            jnp.stack(conv_s), jnp.stack(C_s), jnp.stack(n_s), jnp.stack(m_s), jnp.stack(v_s))
```

```cpp
#include <hip/hip_runtime.h>
#include <hip/hip_cooperative_groups.h>
#include <cstdio>
#include <cstdint>

constexpr int D = 2048, NP = 8192, NS = 512, M = NP + NS, FF = 5632, DPLE = 256;
constexpr int NZ = 14336;
constexpr int NZG = NZ + 256;
constexpr int SEQ = 2048, DECB = 128;
constexpr float EPS = 1e-6f;

namespace pg8 {
#define PG8_LAS __attribute__((address_space(3)))
typedef unsigned short bf16_t;
typedef short bf16x8 __attribute__((ext_vector_type(8)));
typedef float f32x4 __attribute__((ext_vector_type(4)));
typedef unsigned u32x4 __attribute__((ext_vector_type(4)));
constexpr int BM = 256, BK = 64, HALF = 128, HTB = HALF * BK * 2  , STAGE_BYTES = 8 * HTB, NXCD = 8, WGM = 4;

__host__ __device__ __forceinline__ int lds_byte(int r, int c) { const int st = (r >> 4) * 2 + (c >> 5), rr = r & 15, cc = c & 31, ob = rr * 64 + cc * 2; return st * 1024 + (ob ^ (((ob >> 9) & 1) << 5)); }
__host__ __device__ __forceinline__ void stage_rc(int b, int& R, int& C) { const int st = b / 1024, sb = b % 1024, swz = sb ^ (((sb >> 9) & 1) << 5); R = (st >> 1) * 16 + swz / 64; C = (st & 1) * 32 + (swz % 64) / 2; }
__host__ __device__ __forceinline__ int perm32(int rho) { const int n = rho >> 4, i = rho & 15; return 8 * (i >> 2) + 4 * n + (i & 3); }

struct Unit { int pm, pn, kt0; };
struct Gemm { const bf16_t* A; const bf16_t* Bt; int M, N, K, nt; };

struct StaticOrder {
    int nM, nN, nwg, G, c;
    __host__ __device__ void init(int M, int N, int G_, int c_) { nM = M / BM; nN = N / BM; nwg = nM * nN; G = G_; c = c_; }
    __host__ __device__ bool next(int i, Unit& u) const {
        const long L = (long)i * G + c; if (L >= nwg) return false;
        int wgid = (int)L; { const int q = nwg / NXCD, r = nwg % NXCD, xcd = wgid % NXCD, off = wgid / NXCD; wgid = (xcd < r ? xcd * (q + 1) : r * (q + 1) + (xcd - r) * q) + off; }
        const int nig = WGM * nN, gid = wgid / nig, fm = gid * WGM, gsz = (nM - fm) < WGM ? (nM - fm) : WGM;
        u.pm = fm + ((wgid % nig) % gsz); u.pn = (wgid % nig) / gsz; u.kt0 = 0; return true;
    }
    __device__ __forceinline__ void a_ready(const Unit&) const {}
    __device__ __forceinline__ void done(const Unit&) const {}
};

__device__ __forceinline__ unsigned cvt_pk_bf16(float lo, float hi) { unsigned r; asm volatile("v_cvt_pk_bf16_f32 %0, %1, %2" : "=v"(r) : "v"(lo), "v"(hi)); return r; }
typedef float f32x2 __attribute__((ext_vector_type(2)));
__device__ __forceinline__ f32x2 gelu_pk(f32x2 v) {
    const f32x2 av = __builtin_elementwise_abs(v), d = av * 0.2316418882f + 1.0f;
    f32x2 t; t.x = __builtin_amdgcn_rcpf(d.x); t.y = __builtin_amdgcn_rcpf(d.y);
    f32x2 q = t * 0.5307027145f + (-0.7265760135f); q = q * t + 0.7107068705f; q = q * t + (-0.142248368f); q = q * t + 0.127414796f; q = q * t;
    const f32x2 s = (v * v) * (-0.72134752044f);
    f32x2 e; e.x = __builtin_amdgcn_exp2f(s.x); e.y = __builtin_amdgcn_exp2f(s.y);
    const f32x2 m = v * (q * e), r = v - m;
    f32x2 o; o.x = v.x < 0.f ? m.x : r.x; o.y = v.y < 0.f ? m.y : r.y; return o;
}


typedef unsigned u32x2 __attribute__((ext_vector_type(2)));
__device__ __forceinline__ float sigm(float x) { return __builtin_amdgcn_rcpf(1.0f + __expf(-x)); }
__device__ __forceinline__ f32x4 sigm4(f32x4 v) { return (f32x4){sigm(v[0]), sigm(v[1]), sigm(v[2]), sigm(v[3])}; }
__device__ __forceinline__ f32x4 gelu4(f32x4 v) { const f32x2 a = gelu_pk((f32x2){v[0], v[1]}), b = gelu_pk((f32x2){v[2], v[3]}); return (f32x4){a.x, a.y, b.x, b.y}; }
__device__ __forceinline__ float bfl(unsigned w) { return __uint_as_float(w << 16); }
__device__ __forceinline__ float bfh(unsigned w) { return __uint_as_float(w & 0xffff0000u); }

struct EpiF32 {
    static constexpr bool PERM = false, AFTER_DRAIN = false, MIDHOOK = false;
    float* C; int ldc;
    __device__ __forceinline__ void operator()(const f32x4 (&acc)[2][2][4][2], const Unit& u, int wr, int wc, int fr, int fq) const {
        const int row0 = u.pm * BM + wr * 64 + fr, col0 = u.pn * BM + wc * 32 + 4 * fq;
#pragma unroll
        for (int ai = 0; ai < 2; ++ai)
#pragma unroll
            for (int m = 0; m < 4; ++m) { float* rowp = C + (size_t)(row0 + ai * HALF + m * 16) * ldc + col0;
#pragma unroll
                for (int bj = 0; bj < 2; ++bj)
#pragma unroll
                    for (int n = 0; n < 2; ++n) *(f32x4*)(rowp + bj * HALF + n * 16) = acc[ai][bj][m][n]; }
    }
};
struct EpiSwiGLU {
    static constexpr bool PERM = true, AFTER_DRAIN = false, MIDHOOK = false;
    bf16_t* O; int ldc;
    __device__ __forceinline__ void operator()(const f32x4 (&acc)[2][2][4][2], const Unit& u, int wr, int wc, int fr, int fq) const {
        const int row0 = u.pm * BM + wr * 64 + fr, col0 = u.pn * HALF + wc * 32 + 8 * fq;
#pragma unroll
        for (int ai = 0; ai < 2; ++ai)
#pragma unroll
            for (int m = 0; m < 4; ++m) { bf16_t* rowp = O + (size_t)(row0 + ai * HALF + m * 16) * ldc + col0;
                const f32x4 g0 = acc[ai][0][m][0], g1 = acc[ai][0][m][1], u0 = acc[ai][1][m][0], u1 = acc[ai][1][m][1];
                const f32x4 h0 = g0 * sigm4(g0) * u0, h1 = g1 * sigm4(g1) * u1;
                u32x4 w; w.x = cvt_pk_bf16(h0[0], h0[1]); w.y = cvt_pk_bf16(h0[2], h0[3]); w.z = cvt_pk_bf16(h1[0], h1[1]); w.w = cvt_pk_bf16(h1[2], h1[3]);
                *(u32x4*)rowp = w; }
    }
};
struct EpiZ {
    static constexpr bool PERM = true, AFTER_DRAIN = false, MIDHOOK = false;
    bf16_t* Z; float* stat; float* conv_p; float* conv_s; float* gates; const float* b_i; const float* b_f;
    __device__ __forceinline__ void operator()(const f32x4 (&acc)[2][2][4][2], const Unit& u, int wr, int wc, int fr, int fq) const {
        const int sec = u.pn >> 3, pnl = u.pn & 7;
        if (sec == 7) {
            if (wc == 0 && fq == 0) { const f32x4 bi = *(const f32x4*)b_i, bf = *(const f32x4*)b_f;
#pragma unroll
                for (int ai = 0; ai < 2; ++ai)
#pragma unroll
                    for (int m = 0; m < 4; ++m) { const int r = u.pm * BM + wr * 64 + fr + ai * HALF + m * 16; const f32x4 x = acc[ai][0][m][1] + bf; f32x4 lf;
#pragma unroll
                        for (int e = 0; e < 4; ++e) lf[e] = fminf(x[e], 0.f) - __logf(1.0f + __expf(-fabsf(x[e])));
                        *(f32x4*)(gates + (size_t)r * 8) = acc[ai][0][m][0] + bi; *(f32x4*)(gates + (size_t)r * 8 + 4) = lf; } }
            return; }
        bf16_t* Zs = Z + (size_t)sec * ((size_t)M * D);
        const int row0 = u.pm * BM + wr * 64 + fr, col0 = pnl * BM + wc * 32 + 8 * fq;
#pragma unroll
        for (int ai = 0; ai < 2; ++ai)
#pragma unroll
            for (int m = 0; m < 4; ++m) { const int r = row0 + ai * HALF + m * 16; float s1 = 0.f, s2 = 0.f;
#pragma unroll
                for (int bj = 0; bj < 2; ++bj) { f32x4 v0 = acc[ai][bj][m][0], v1 = acc[ai][bj][m][1];
                    if (sec == 0) {
                        float* dst = nullptr;
                        if (r < NP) { const int t = r & (SEQ - 1); if (t >= SEQ - 3) dst = conv_p + (size_t)((r >> 11) * 3 + (t - (SEQ - 3))) * D; }
                        else { const int s = r - NP, t = s & 3; if (t >= 1) dst = conv_s + (size_t)((s >> 2) * 3 + (t - 1)) * D; }
                        if (dst) { *(f32x4*)(dst + col0 + bj * HALF) = v0; *(f32x4*)(dst + col0 + bj * HALF + 4) = v1; }
                    } else if (sec == 2 || sec >= 5) { v0 = sigm4(v0); v1 = sigm4(v1); }
                    else if (sec >= 3) { v0 = gelu4(v0); v1 = gelu4(v1);
                        if (sec == 4) { s1 += (v0[0] + v0[1]) + (v0[2] + v0[3]) + (v1[0] + v1[1]) + (v1[2] + v1[3]);
                            s2 += (v0[0] * v0[0] + v0[1] * v0[1]) + (v0[2] * v0[2] + v0[3] * v0[3]) + (v1[0] * v1[0] + v1[1] * v1[1]) + (v1[2] * v1[2] + v1[3] * v1[3]); } }
                    u32x4 w; w.x = cvt_pk_bf16(v0[0], v0[1]); w.y = cvt_pk_bf16(v0[2], v0[3]); w.z = cvt_pk_bf16(v1[0], v1[1]); w.w = cvt_pk_bf16(v1[2], v1[3]);
                    *(u32x4*)(Zs + (size_t)r * D + col0 + bj * HALF) = w; }
                if (sec == 4) { s1 += __shfl_xor(s1, 16); s1 += __shfl_xor(s1, 32); s2 += __shfl_xor(s2, 16); s2 += __shfl_xor(s2, 32);
                    if (fq == 0) { float* sp = stat + ((size_t)r * 32 + pnl * 4 + wc) * 2; sp[0] = s1; sp[1] = s2; } } }
    }
};
struct ZOrder {
    StaticOrder s;
    __device__ bool next(int i, Unit& u) const { if (!s.next(i, u)) return false; const int p = u.pn; u.pn = p < 56 ? (p % 7) * 8 + p / 7 : p; return true; }
    __device__ __forceinline__ void a_ready(const Unit&) const {}
    __device__ __forceinline__ void done(const Unit&) const {}
};
struct EpiDual {
    static constexpr bool PERM = false, AFTER_DRAIN = false, MIDHOOK = false;
    const bf16_t* GA; const bf16_t* GB; float* T; bf16_t* MIX;
    __device__ __forceinline__ void operator()(const f32x4 (&acc)[2][2][4][2], const Unit& u, int wr, int wc, int fr, int fq) const {
        const int pass = u.pm >= (M / BM) ? 1 : 0, pm = u.pm - pass * (M / BM), pn = u.pn - pass * (D / BM);
        const bf16_t* G = pass ? GB : GA;
        const int row0 = pm * BM + wr * 64 + fr, col0 = pn * BM + wc * 32 + 4 * fq;
#pragma unroll
        for (int ai = 0; ai < 2; ++ai)
#pragma unroll
            for (int m = 0; m < 4; ++m) { const size_t ro = (size_t)(row0 + ai * HALF + m * 16) * D + col0;
#pragma unroll
                for (int bj = 0; bj < 2; ++bj)
#pragma unroll
                    for (int n = 0; n < 2; ++n) { const size_t o = ro + bj * HALF + n * 16;
                        const u32x2 gw = *(const u32x2*)(G + o); const f32x4 g = (f32x4){bfl(gw.x), bfh(gw.x), bfl(gw.y), bfh(gw.y)};
                        const f32x4 v = g * acc[ai][bj][m][n];
                        if (!pass) *(f32x4*)(T + o) = v;
                        else { const f32x4 s = *(const f32x4*)(T + o) + v; u32x2 w; w.x = cvt_pk_bf16(s[0], s[1]); w.y = cvt_pk_bf16(s[2], s[3]); *(u32x2*)(MIX + o) = w; } }
                asm volatile("" ::: "memory"); }
    }
};
struct EpiPle {
    static constexpr bool PERM = false, AFTER_DRAIN = false, MIDHOOK = false;
    const float* PUP; float* T;
    __device__ __forceinline__ void operator()(const f32x4 (&acc)[2][2][4][2], const Unit& u, int wr, int wc, int fr, int fq) const {
        const int row0 = u.pm * BM + wr * 64 + fr, col0 = u.pn * BM + wc * 32 + 4 * fq;
#pragma unroll
        for (int ai = 0; ai < 2; ++ai)
#pragma unroll
            for (int m = 0; m < 4; ++m) { const size_t ro = (size_t)(row0 + ai * HALF + m * 16) * D + col0;
#pragma unroll
                for (int bj = 0; bj < 2; ++bj)
#pragma unroll
                    for (int n = 0; n < 2; ++n) { const size_t o = ro + bj * HALF + n * 16; *(f32x4*)(T + o) = sigm4(acc[ai][bj][m][n]) * *(const f32x4*)(PUP + o); }
                asm volatile("" ::: "memory"); }
    }
};
struct DualOrder {
    StaticOrder s;
    __device__ bool next(int i, Unit& u) const { Unit t; if (!s.next(i >> 1, t)) return false; const int pass = i & 1; u.pm = t.pm + pass * (M / BM); u.pn = t.pn + pass * (D / BM); u.kt0 = 0; return true; }
    __device__ __forceinline__ void a_ready(const Unit&) const {}
    __device__ __forceinline__ void done(const Unit&) const {}
};


struct SplitOrder {
    int c, S, ntsub, dual;
    __device__ bool next(int i, Unit& u) const { int dl = dual; asm volatile("" : "+s"(dl));
        if (c >= 16 * S || i >= 1 + dl) return false; const int tile = c & 15, slice = c >> 4;
        u.pm = NP / BM + (tile >> 3) + i * (M / BM); u.pn = (tile & 7) + i * (D / BM); u.kt0 = slice * ntsub; return true; }
    __device__ __forceinline__ void a_ready(const Unit&) const {}
    __device__ __forceinline__ void done(const Unit&) const {}
};
struct EpiSlab {
    static constexpr bool PERM = false, AFTER_DRAIN = false, MIDHOOK = false;
    float* slab; int ntsub;
    __device__ __forceinline__ void operator()(const f32x4 (&acc)[2][2][4][2], const Unit& u, int wr, int wc, int fr, int fq) const {
        float* C = slab + (size_t)(u.kt0 / ntsub) * ((size_t)NS * D);
        const int row0 = (u.pm - NP / BM) * BM + wr * 64 + fr, col0 = u.pn * BM + wc * 32 + 4 * fq;
#pragma unroll
        for (int ai = 0; ai < 2; ++ai)
#pragma unroll
            for (int m = 0; m < 4; ++m) { float* rowp = C + (size_t)(row0 + ai * HALF + m * 16) * D + col0;
#pragma unroll
                for (int bj = 0; bj < 2; ++bj)
#pragma unroll
                    for (int n = 0; n < 2; ++n) *(f32x4*)(rowp + bj * HALF + n * 16) = acc[ai][bj][m][n]; }
    }
};
struct EpiDualSlab {
    static constexpr bool PERM = false, AFTER_DRAIN = false, MIDHOOK = false;
    const bf16_t* GA; const bf16_t* GB; float* slab; int ntsub;
    __device__ __forceinline__ void operator()(const f32x4 (&acc)[2][2][4][2], const Unit& u, int wr, int wc, int fr, int fq) const {
        const int pass = u.pm >= (NP / BM + M / BM) ? 1 : 0, pm = u.pm - NP / BM - pass * (M / BM), pn = u.pn - pass * (D / BM);
        const bf16_t* G = (pass ? GB : GA) + (size_t)NP * D;
        float* C = slab + (size_t)(u.kt0 / ntsub) * ((size_t)NS * D);
        const int row0 = pm * BM + wr * 64 + fr, col0 = pn * BM + wc * 32 + 4 * fq;
#pragma unroll
        for (int ai = 0; ai < 2; ++ai)
#pragma unroll
            for (int m = 0; m < 4; ++m) { const size_t ro = (size_t)(row0 + ai * HALF + m * 16) * D + col0;
#pragma unroll
                for (int bj = 0; bj < 2; ++bj)
#pragma unroll
                    for (int n = 0; n < 2; ++n) { const size_t o = ro + bj * HALF + n * 16;
                        const u32x2 gw = *(const u32x2*)(G + o); const f32x4 g = (f32x4){bfl(gw.x), bfh(gw.x), bfl(gw.y), bfh(gw.y)};
                        const f32x4 v = g * acc[ai][bj][m][n];
                        if (!pass) *(f32x4*)(C + o) = v; else *(f32x4*)(C + o) = *(const f32x4*)(C + o) + v; }
                asm volatile("" ::: "memory"); }
    }
};


__device__ __forceinline__ void unpack8(u32x4 w, f32x4& lo, f32x4& hi) { lo = (f32x4){bfl(w.x), bfh(w.x), bfl(w.y), bfh(w.y)}; hi = (f32x4){bfl(w.z), bfh(w.z), bfl(w.w), bfh(w.w)}; }
struct EpiMerge {
    static constexpr bool PERM = true, AFTER_DRAIN = false, MIDHOOK = true;
    const bf16_t* GA; const bf16_t* GB; bf16_t* MIX;
    __device__ __forceinline__ void mid(f32x4 (&acc)[2][2][4][2], const Unit& u, int wr, int wc, int fr, int fq) const {
        int lo_ = fr * D + 8 * fq; asm volatile("" : "+v"(lo_));
        const unsigned base = (unsigned)((u.pm * BM + wr * 64) * D + u.pn * BM + wc * 32) + (unsigned)lo_;
#pragma unroll
        for (int ai = 0; ai < 2; ++ai)
#pragma unroll
            for (int m = 0; m < 4; ++m) { const unsigned ro = base + (unsigned)((ai * HALF + m * 16) * D);
#pragma unroll
                for (int bj = 0; bj < 2; ++bj) { const u32x4 aw = *(const u32x4*)(GA + ro + bj * HALF), bw = *(const u32x4*)(GB + ro + bj * HALF);
                    f32x4 a0, a1, b0, b1; unpack8(aw, a0, a1); unpack8(bw, b0, b1);
#pragma unroll
                    for (int e = 0; e < 4; ++e) { acc[ai][bj][m][0][e] *= a0[e] * __builtin_amdgcn_rcpf(fmaxf(b0[e], 1e-20f)); acc[ai][bj][m][1][e] *= a1[e] * __builtin_amdgcn_rcpf(fmaxf(b1[e], 1e-20f)); } }
                asm volatile("" ::: "memory"); }
    }
    __device__ __forceinline__ void operator()(const f32x4 (&acc)[2][2][4][2], const Unit& u, int wr, int wc, int fr, int fq) const {
        const int row0 = u.pm * BM + wr * 64 + fr, col0 = u.pn * BM + wc * 32 + 8 * fq;
#pragma unroll
        for (int ai = 0; ai < 2; ++ai)
#pragma unroll
            for (int m = 0; m < 4; ++m) { const size_t ro = (size_t)(row0 + ai * HALF + m * 16) * D + col0;
#pragma unroll
                for (int bj = 0; bj < 2; ++bj) { const u32x4 bw = *(const u32x4*)(GB + ro + bj * HALF); f32x4 b0, b1; unpack8(bw, b0, b1);
                    f32x4 v0 = acc[ai][bj][m][0], v1 = acc[ai][bj][m][1];
#pragma unroll
                    for (int e = 0; e < 4; ++e) { v0[e] *= fmaxf(b0[e], 1e-20f); v1[e] *= fmaxf(b1[e], 1e-20f); }
                    u32x4 w; w.x = cvt_pk_bf16(v0[0], v0[1]); w.y = cvt_pk_bf16(v0[2], v0[3]); w.z = cvt_pk_bf16(v1[0], v1[1]); w.w = cvt_pk_bf16(v1[2], v1[3]);
                    *(u32x4*)(MIX + ro + bj * HALF) = w; }
                asm volatile("" ::: "memory"); }
    }
};
struct EpiMergeSlab {
    static constexpr bool PERM = false, AFTER_DRAIN = false, MIDHOOK = false;
    const bf16_t* GA; const bf16_t* GB; float* slab; int ntsub;
    __device__ __forceinline__ void operator()(const f32x4 (&acc)[2][2][4][2], const Unit& u, int wr, int wc, int fr, int fq) const {
        const int slice = u.kt0 / ntsub;
        const bf16_t* G = (slice >= 4 ? GB : GA) + (size_t)NP * D;
        float* C = slab + (size_t)slice * ((size_t)NS * D);
        const int row0 = (u.pm - NP / BM) * BM + wr * 64 + fr, col0 = u.pn * BM + wc * 32 + 4 * fq;
#pragma unroll
        for (int ai = 0; ai < 2; ++ai)
#pragma unroll
            for (int m = 0; m < 4; ++m) { const size_t ro = (size_t)(row0 + ai * HALF + m * 16) * D + col0;
#pragma unroll
                for (int bj = 0; bj < 2; ++bj)
#pragma unroll
                    for (int n = 0; n < 2; ++n) { const size_t o = ro + bj * HALF + n * 16;
                        const u32x2 gw = *(const u32x2*)(G + o); const f32x4 g = (f32x4){bfl(gw.x), bfh(gw.x), bfl(gw.y), bfh(gw.y)};
                        *(f32x4*)(C + o) = g * acc[ai][bj][m][n]; }
                asm volatile("" ::: "memory"); }
    }
};

struct EpiT16 {
    static constexpr bool PERM = true, AFTER_DRAIN = false, MIDHOOK = false;
    bf16_t* O;
    __device__ __forceinline__ void operator()(const f32x4 (&acc)[2][2][4][2], const Unit& u, int wr, int wc, int fr, int fq) const {
        const int row0 = u.pm * BM + wr * 64 + fr, col0 = u.pn * BM + wc * 32 + 8 * fq;
#pragma unroll
        for (int ai = 0; ai < 2; ++ai)
#pragma unroll
            for (int m = 0; m < 4; ++m) { bf16_t* rowp = O + (size_t)(row0 + ai * HALF + m * 16) * D + col0;
#pragma unroll
                for (int bj = 0; bj < 2; ++bj) { const f32x4 v0 = acc[ai][bj][m][0], v1 = acc[ai][bj][m][1];
                    u32x4 w; w.x = cvt_pk_bf16(v0[0], v0[1]); w.y = cvt_pk_bf16(v0[2], v0[3]); w.z = cvt_pk_bf16(v1[0], v1[1]); w.w = cvt_pk_bf16(v1[2], v1[3]);
                    *(u32x4*)(rowp + bj * HALF) = w; } }
    }
};
struct EpiPle16 {
    static constexpr bool PERM = true, AFTER_DRAIN = false, MIDHOOK = false;
    const bf16_t* PUP; bf16_t* T;
    __device__ __forceinline__ void operator()(const f32x4 (&acc)[2][2][4][2], const Unit& u, int wr, int wc, int fr, int fq) const {
        const int row0 = u.pm * BM + wr * 64 + fr, col0 = u.pn * BM + wc * 32 + 8 * fq;
#pragma unroll
        for (int ai = 0; ai < 2; ++ai)
#pragma unroll
            for (int m = 0; m < 4; ++m) { const size_t ro = (size_t)(row0 + ai * HALF + m * 16) * D + col0;
#pragma unroll
                for (int bj = 0; bj < 2; ++bj) { const u32x4 pw = *(const u32x4*)(PUP + ro + bj * HALF); f32x4 p0, p1; unpack8(pw, p0, p1);
                    const f32x4 v0 = sigm4(acc[ai][bj][m][0]) * p0, v1 = sigm4(acc[ai][bj][m][1]) * p1;
                    u32x4 w; w.x = cvt_pk_bf16(v0[0], v0[1]); w.y = cvt_pk_bf16(v0[2], v0[3]); w.z = cvt_pk_bf16(v1[0], v1[1]); w.w = cvt_pk_bf16(v1[2], v1[3]);
                    *(u32x4*)(T + ro + bj * HALF) = w; }
                asm volatile("" ::: "memory"); }
    }
};
template <class Epi, class Sched, bool ALIGN_EPI = false, bool SP2 = false>
__device__ __forceinline__ void gemm_phase(PG8_LAS unsigned char* lds, const Gemm g, const Sched& S, const Epi& E) {
    int tid_ = threadIdx.x; asm volatile("" : "+v"(tid_));
    const int tid = tid_, wid = __builtin_amdgcn_readfirstlane(tid >> 6), lane = tid & 63, wr = wid >> 2, wc = wid & 3, fr = lane & 15, fq = lane >> 4;
    const int K = g.K, nt = __builtin_amdgcn_readfirstlane(g.nt);
    unsigned voffA[2], voffB[2];
#pragma unroll
    for (int i = 0; i < 2; ++i) { int R, C; stage_rc(tid * 16 + i * 8192, R, C); const int Rb = Epi::PERM ? ((R & ~31) + perm32(R & 31)) : R;
        voffA[i] = (unsigned)(R * K + C) * 2u; voffB[i] = (unsigned)(Rb * K + C) * 2u; }
    const size_t kstep = (size_t)(BK * 2);
    const size_t hstep = (size_t)HALF * K * 2;
    const size_t tstep = 2 * hstep;
    const unsigned ldsw = (unsigned)wid * 1024u;
    const int aoff = lds_byte(wr * 64 + fr, fq * 8), boff = lds_byte(wc * 32 + fr, fq * 8);
#define PG8_SA(b, h) (((b) * 2 + (h)) * HTB)
#define PG8_SB(b, h) ((4 + (b) * 2 + (h)) * HTB)
#define PG8_STAGE(bufoff, gbase, voff) do { _Pragma("unroll") for (int _i = 0; _i < 2; ++_i) \
        __builtin_amdgcn_global_load_lds((const unsigned*)((const char*)(gbase) + (voff)[_i]), (PG8_LAS unsigned*)(lds + (bufoff) + ldsw + _i * 8192), 16, 0, 0); } while (0)
#define PG8_LDA(dst, b, h) do { _Pragma("unroll") for (int m = 0; m < 4; ++m) _Pragma("unroll") for (int k = 0; k < 2; ++k) dst[m][k] = *(const PG8_LAS bf16x8*)(lds + PG8_SA(b, h) + aoff + m * 2048 + k * 1024); } while (0)
#define PG8_LDB(dst, b, h) do { _Pragma("unroll") for (int n = 0; n < 2; ++n) _Pragma("unroll") for (int k = 0; k < 2; ++k) dst[n][k] = *(const PG8_LAS bf16x8*)(lds + PG8_SB(b, h) + boff + n * 2048 + k * 1024); } while (0)
#define PG8_MMA(ai, bj, At, Bt) do { __builtin_amdgcn_s_setprio(1); _Pragma("unroll") for (int m = 0; m < 4; ++m) _Pragma("unroll") for (int n = 0; n < 2; ++n) _Pragma("unroll") for (int k = 0; k < 2; ++k) \
        acc[ai][bj][m][n] = __builtin_amdgcn_mfma_f32_16x16x32_bf16(Bt[n][k], At[m][k], acc[ai][bj][m][n], 0, 0, 0); __builtin_amdgcn_s_setprio(0); } while (0)
#define PG8_WAIT_V(n) asm volatile("s_waitcnt vmcnt(" #n ")" ::: "memory")
#define PG8_WAIT_L(n) asm volatile("s_waitcnt lgkmcnt(" #n ")" ::: "memory")
#define PG8_BAR __builtin_amdgcn_s_barrier()
#define PG8_SCHED __builtin_amdgcn_sched_barrier(0)
    Unit cur, nxt; int ui = 0;
    if (!S.next(0, cur)) return;
    f32x4 acc[2][2][4][2];
#pragma unroll
    for (int a = 0; a < 2; ++a)
#pragma unroll
        for (int b = 0; b < 2; ++b)
#pragma unroll
            for (int m = 0; m < 4; ++m)
#pragma unroll
                for (int n = 0; n < 2; ++n) acc[a][b][m][n] = (f32x4){0.f, 0.f, 0.f, 0.f};
    bf16x8 At[4][2], B0[2][2], B1[2][2];
    const char* cA = (const char*)g.A + (size_t)cur.pm * tstep + (size_t)cur.kt0 * kstep; const char* cB = (const char*)g.Bt + (size_t)cur.pn * tstep + (size_t)cur.kt0 * kstep;
    S.a_ready(cur);
    if constexpr (SP2) {
        PG8_STAGE(PG8_SB(0, 0), cB, voffB); PG8_STAGE(PG8_SB(0, 1), cB + hstep, voffB); PG8_STAGE(PG8_SA(0, 0), cA, voffA); PG8_STAGE(PG8_SA(0, 1), cA + hstep, voffA);
        if (wr == 1) PG8_BAR;
        PG8_WAIT_V(2); PG8_BAR;
        PG8_STAGE(PG8_SB(1, 0), cB + kstep, voffB); PG8_STAGE(PG8_SA(1, 0), cA + kstep, voffA); PG8_STAGE(PG8_SB(1, 1), cB + hstep + kstep, voffB);
        PG8_WAIT_V(6); PG8_BAR;
    } else {
        PG8_STAGE(PG8_SB(0, 0), cB, voffB); PG8_STAGE(PG8_SA(0, 0), cA, voffA); PG8_STAGE(PG8_SB(0, 1), cB + hstep, voffB); PG8_STAGE(PG8_SA(0, 1), cA + hstep, voffA);
        if (wr == 1) PG8_BAR;
        PG8_WAIT_V(4); PG8_BAR;
        PG8_STAGE(PG8_SB(1, 0), cB + kstep, voffB); PG8_STAGE(PG8_SA(1, 0), cA + kstep, voffA); PG8_STAGE(PG8_SB(1, 1), cB + hstep + kstep, voffB);
        PG8_WAIT_V(6); PG8_BAR;
    }
    for (;;) {
        const bool has_next = S.next(ui + 1, nxt);
        const char* nA = has_next ? (const char*)g.A + (size_t)nxt.pm * tstep + (size_t)nxt.kt0 * kstep : cA; const char* nB = has_next ? (const char*)g.Bt + (size_t)nxt.pn * tstep + (size_t)nxt.kt0 * kstep : cB;
        for (int t = 0; t < nt; t += 2) {
            if constexpr (Epi::MIDHOOK) { if (t == (nt >> 1)) E.mid(acc, cur, wr, wc, fr, fq); }
            const bool last = (t == nt - 2);
            const char* a1 = cA + (size_t)(t + 1) * kstep;
            const char* a2 = last ? nA : cA + (size_t)(t + 2) * kstep; const char* b2 = last ? nB : cB + (size_t)(t + 2) * kstep;
            const char* a3 = a2 + kstep; const char* b3 = b2 + kstep;
            if (last && has_next) S.a_ready(nxt);
            if constexpr (SP2) {
            PG8_LDB(B0, 0, 0); PG8_LDB(B1, 0, 1); PG8_SCHED; PG8_LDA(At, 0, 0); PG8_STAGE(PG8_SA(1, 1), a1 + hstep, voffA);
            PG8_WAIT_V(8); PG8_WAIT_L(0); PG8_BAR; PG8_MMA(0, 0, At, B0); PG8_MMA(0, 1, At, B1); PG8_BAR; PG8_SCHED;
            PG8_LDA(At, 0, 1); PG8_STAGE(PG8_SB(0, 0), b2, voffB); PG8_STAGE(PG8_SB(0, 1), b2 + hstep, voffB); PG8_STAGE(PG8_SA(0, 0), a2, voffA);
            PG8_WAIT_V(8); PG8_WAIT_L(0); PG8_BAR; PG8_MMA(1, 0, At, B0); PG8_MMA(1, 1, At, B1); PG8_BAR; PG8_SCHED;
            PG8_LDB(B0, 1, 0); PG8_LDB(B1, 1, 1); PG8_SCHED; PG8_LDA(At, 1, 0); PG8_STAGE(PG8_SA(0, 1), a2 + hstep, voffA);
            PG8_WAIT_V(8); PG8_WAIT_L(0); PG8_BAR; PG8_MMA(0, 0, At, B0); PG8_MMA(0, 1, At, B1); PG8_BAR; PG8_SCHED;
            PG8_LDA(At, 1, 1); PG8_STAGE(PG8_SB(1, 0), b3, voffB); PG8_STAGE(PG8_SB(1, 1), b3 + hstep, voffB); PG8_STAGE(PG8_SA(1, 0), a3, voffA);
            PG8_WAIT_V(8); PG8_WAIT_L(0); PG8_BAR; PG8_MMA(1, 0, At, B0); PG8_MMA(1, 1, At, B1); PG8_BAR; PG8_SCHED;
            } else {
            PG8_LDB(B0, 0, 0); PG8_SCHED; PG8_LDA(At, 0, 0); PG8_STAGE(PG8_SA(1, 1), a1 + hstep, voffA);
            PG8_WAIT_L(8); PG8_BAR; PG8_WAIT_L(0); PG8_MMA(0, 0, At, B0); PG8_BAR; PG8_SCHED;
            PG8_LDB(B1, 0, 1); PG8_STAGE(PG8_SB(0, 0), b2, voffB);
            PG8_BAR; PG8_WAIT_L(0); PG8_MMA(0, 1, At, B1); PG8_BAR;
            PG8_LDA(At, 0, 1); PG8_STAGE(PG8_SA(0, 0), a2, voffA);
            PG8_BAR; PG8_WAIT_L(0); PG8_MMA(1, 0, At, B0); PG8_BAR; PG8_SCHED;
            PG8_STAGE(PG8_SB(0, 1), b2 + hstep, voffB);
            PG8_WAIT_V(6); PG8_BAR; PG8_MMA(1, 1, At, B1); PG8_BAR;
            PG8_LDB(B0, 1, 0); PG8_SCHED; PG8_LDA(At, 1, 0); PG8_STAGE(PG8_SA(0, 1), a2 + hstep, voffA);
            PG8_WAIT_L(8); PG8_BAR; PG8_WAIT_L(0); PG8_MMA(0, 0, At, B0); PG8_BAR; PG8_SCHED;
            PG8_LDB(B1, 1, 1); PG8_STAGE(PG8_SB(1, 0), b3, voffB);
            PG8_BAR; PG8_WAIT_L(0); PG8_MMA(0, 1, At, B1); PG8_BAR;
            PG8_LDA(At, 1, 1); PG8_STAGE(PG8_SA(1, 0), a3, voffA);
            PG8_BAR; PG8_WAIT_L(0); PG8_MMA(1, 0, At, B0); PG8_BAR; PG8_SCHED;
            PG8_STAGE(PG8_SB(1, 1), b3 + hstep, voffB);
            PG8_WAIT_V(6); PG8_BAR; PG8_MMA(1, 1, At, B1); PG8_BAR;
            }
        }
        if constexpr (ALIGN_EPI) { if (wr == 0) PG8_BAR; }
        if constexpr (!Epi::AFTER_DRAIN) { E(acc, cur, wr, wc, fr, fq); S.done(cur); } else { if (has_next) { E(acc, cur, wr, wc, fr, fq); S.done(cur); } }
        if (!has_next) break;
#pragma unroll
        for (int a = 0; a < 2; ++a)
#pragma unroll
            for (int b = 0; b < 2; ++b)
#pragma unroll
                for (int m = 0; m < 4; ++m)
#pragma unroll
                    for (int n = 0; n < 2; ++n) acc[a][b][m][n] = (f32x4){0.f, 0.f, 0.f, 0.f};
        cur = nxt; cA = nA; cB = nB; ++ui;
        if constexpr (ALIGN_EPI) { if (wr == 1) PG8_BAR; }
    }
    PG8_WAIT_V(0);
    if constexpr (!ALIGN_EPI) { if (wr == 0) PG8_BAR; }
    PG8_BAR;
    if constexpr (Epi::AFTER_DRAIN) { E.fused(acc, cur, wr, wc, fr, fq, lds, wid, lane); S.done(cur); }
#undef PG8_SA
#undef PG8_SB
#undef PG8_STAGE
#undef PG8_LDA
#undef PG8_LDB
#undef PG8_MMA
#undef PG8_WAIT_V
#undef PG8_WAIT_L
#undef PG8_BAR
#undef PG8_SCHED
}
}

constexpr int NWAVES = 8;
#ifndef MK_SINGLE
#define MK_SINGLE 1
#endif
constexpr int N_PHASES = 17;

enum { I_XP = 0, I_XS, I_PP, I_PS, I_SCONV, I_SC, I_SN, I_SM, I_G1PRE, I_W1G, I_W1U, I_W1D, I_G1POST, I_GMIXPRE, I_WIN, I_WCONV, I_BCONV, I_BI, I_BF, I_GHEAD, I_WAOUT,
       I_GLN, I_BLN, I_WSP, I_BSP, I_WBOUT, I_WO, I_GMIXPOST, I_G2PRE, I_W2G, I_W2U, I_W2D, I_G2POST, I_GPLEPRE, I_WPG, I_WPU, I_GPLEPOST, N_IN };
constexpr size_t O_Y = 0, O_CONVP = (size_t)M * D, O_CP = O_CONVP + 4 * 3 * 2048, O_NP = O_CP + (size_t)16 * 256 * 512, O_MP = O_NP + 16 * 256, O_CONVS = O_MP + 16,
                 O_CS = O_CONVS + (size_t)128 * 3 * 2048, O_NS = O_CS + (size_t)512 * 256 * 512, O_MS = O_NS + 512 * 256, O_VS = O_MS + 512, O_END = O_VS + (size_t)NS * D;
static_assert(O_END == 89027088, "output size");

constexpr size_t MiB = 1u << 20;
constexpr size_t WS_CTL = 0, CTL_ZERO_BYTES = 1 * MiB;
constexpr size_t WS_W1 = 1 * MiB, WS_W1D = WS_W1 + 44 * MiB, WS_WIN = WS_W1D + 22 * MiB, WS_WAB = WS_WIN + 57 * MiB, WS_WO = WS_WAB + 16 * MiB, WS_WPG = WS_WO + 8 * MiB,
                 WS_WPU = WS_WPG + 8 * MiB, WS_W2 = WS_WPU + 1 * MiB, WS_W2D = WS_W2 + 44 * MiB, WS_WGT = WS_W2D + 22 * MiB, WS_PB = WS_WGT + 1 * MiB, WS_XN = WS_PB + 5 * MiB,
                 WS_HFF = WS_XN + 34 * MiB, WS_T32 = WS_HFF + 94 * MiB, WS_H = WS_T32 + 68 * MiB, WS_Z = WS_H + 68 * MiB, WS_QC = WS_Z + 238 * MiB, WS_KC = WS_QC + 17 * MiB,
                 WS_GATES = WS_KC + 17 * MiB, WS_STAT = WS_GATES + 1 * MiB, WS_HRAW = WS_STAT + 3 * MiB, WS_AB = WS_HRAW + 68 * MiB, WS_MIX = WS_AB + 68 * MiB, WS_SLAB = WS_MIX + 34 * MiB, WS_SCT = WS_SLAB + 32 * MiB, WS_SRAW = WS_SCT + 1 * MiB, WS_DENINV = WS_SRAW + 4 * MiB, WS_END = WS_DENINV + 1 * MiB;
constexpr size_t WS_PUP = WS_Z;
static_assert((size_t)11264 * 2048 * 2 == 44 * MiB && (size_t)M * D * 2 == 34 * MiB && (size_t)M * D * 4 == 68 * MiB && (size_t)M * FF * 2 <= 94 * MiB && (size_t)NZG * D * 2 == 57 * MiB, "ws map");
static_assert(WS_END <= 1024 * MiB, "workspace");
constexpr int CW_BAR = 4096, CW_QUEUE = 2048, CW_MIXCNT = 2176;

constexpr int LDS_PHASE_BYTES = 155648;
constexpr int MISC_OFF = LDS_PHASE_BYTES;
constexpr int LDS_BYTES = LDS_PHASE_BYTES + 256;

#define GAS __attribute__((address_space(1)))
#define LAS __attribute__((address_space(3)))
typedef unsigned short bf16;
typedef unsigned v4u __attribute__((ext_vector_type(4)));
typedef unsigned v2u __attribute__((ext_vector_type(2)));
typedef float f32x4 __attribute__((ext_vector_type(4)));
typedef short bf16x8 __attribute__((ext_vector_type(8)));
typedef GAS unsigned gu32;
#define RLX_AGENT __ATOMIC_RELAXED, __HIP_MEMORY_SCOPE_AGENT
#define LDS_WAIT() asm volatile("s_waitcnt lgkmcnt(0)" ::: "memory")
#define VM_WAIT() asm volatile("s_waitcnt vmcnt(0)" ::: "memory")
__device__ __forceinline__ unsigned f2bf(float f) { unsigned u = __builtin_bit_cast(unsigned, f); return (u + 0x7fffu + ((u >> 16) & 1u)) >> 16; }
__device__ __forceinline__ unsigned pk2(float lo, float hi) { return f2bf(lo) | (f2bf(hi) << 16); }
__device__ __forceinline__ float bflo(unsigned w) { return __uint_as_float(w << 16); }
__device__ __forceinline__ float bfhi(unsigned w) { return __uint_as_float(w & 0xffff0000u); }
__device__ __forceinline__ float bf2f(bf16 b) { return __uint_as_float((unsigned)b << 16); }
__device__ __forceinline__ float sigmf(float x) { return __builtin_amdgcn_rcpf(1.0f + __expf(-x)); }
__device__ __forceinline__ float wave_sum(float v) {
#pragma unroll
    for (int o = 1; o < 64; o <<= 1) v += __shfl_xor(v, o);
    return v;
}
__device__ __forceinline__ float dot4(f32x4 a, f32x4 b) { return (a[0] * b[0] + a[1] * b[1]) + (a[2] * b[2] + a[3] * b[3]); }

#define XB_TMO      128
#define XB_XCNT(j)  (256  + 64 * (j))
#define XB_XSUB(j)  (1280 + 64 * (j))
#define XB_XGEN(j)  (2304 + 64 * (j))
#define XB_TOP      3328
#define XB_TOPGEN   3392
#define XCD_BAR_WORDS 3456
#define XB_SPIN_CAP (1u << 18)

__device__ __forceinline__ unsigned xb_ld(unsigned* p)              { return __hip_atomic_load(p, __ATOMIC_RELAXED, __HIP_MEMORY_SCOPE_AGENT); }
__device__ __forceinline__ unsigned xb_add(unsigned* p, unsigned v) { return __hip_atomic_fetch_add(p, v, __ATOMIC_RELAXED, __HIP_MEMORY_SCOPE_AGENT); }
__device__ __forceinline__ unsigned xb_xcc_id() { return (unsigned)__builtin_amdgcn_s_getreg((3 << 11) | 20) & 0xFu; }
#define XB_SPIN(cond, bar) do { unsigned _sp = 0; while (cond) { __builtin_amdgcn_s_sleep(1); \
    if ((++_sp & 255u) == 0u) { if (xb_ld(&(bar)[XB_TMO])) break; if (_sp > XB_SPIN_CAP) { atomicAdd(&(bar)[XB_TMO], 1u); break; } } } } while (0)

struct XcdBarrier {
    unsigned* bar; unsigned x;
    volatile LAS unsigned* st;
};

__device__ __forceinline__ XcdBarrier xcd_barrier_post(unsigned* bar, volatile LAS unsigned* st) {
    XcdBarrier b; b.bar = bar; b.x = xb_xcc_id(); b.st = st;
    if (threadIdx.x == 0) (void)xb_add(&bar[XB_XCNT(b.x)], 1u);
    return b;
}
__device__ __forceinline__ void xcd_barrier_complete(unsigned* bar, unsigned x, unsigned& nloc, unsigned& nx) {
    const unsigned G = gridDim.x * gridDim.y * gridDim.z;
    unsigned sum, cnt, mine, sp = 0u;
    for (;;) {
        sum = 0u; cnt = 0u; mine = 0u;
#pragma unroll
        for (unsigned j = 0; j < 16; ++j) { const unsigned c = xb_ld(&bar[XB_XCNT(j)]); sum += c; cnt += (c > 0u) ? 1u : 0u; mine = (j == x) ? c : mine; }
        if (sum == G) break;
        __builtin_amdgcn_s_sleep(1);
        if ((++sp & 255u) == 0u) { if (xb_ld(&bar[XB_TMO])) break; if (sp > XB_SPIN_CAP) { atomicAdd(&bar[XB_TMO], 1u); break; } }
    }
    nloc = mine > 0u ? mine : 1u; nx = cnt > 0u ? cnt : 1u;
}

__device__ __forceinline__ void xcd_barrier(const XcdBarrier& b) {
    asm volatile("s_waitcnt vmcnt(0)" ::: "memory");
    __syncthreads();
    if (threadIdx.x == 0) {
        unsigned* bar = b.bar;
        __builtin_amdgcn_s_waitcnt(0);
        unsigned nloc = b.st[0], nx = b.st[1];
        if (nloc == 0u) { xcd_barrier_complete(bar, b.x, nloc, nx); b.st[0] = nloc; b.st[1] = nx; }
        const unsigned old = xb_add(&bar[XB_XSUB(b.x)], 1u);
        const unsigned gen = old / nloc;
        if (old + 1u == (gen + 1u) * nloc) {
            __builtin_amdgcn_fence(__ATOMIC_RELEASE, "agent");
            asm volatile("s_waitcnt vmcnt(0)" ::: "memory");
            const unsigned og = xb_add(&bar[XB_TOP], 1u);
            __builtin_amdgcn_fence(__ATOMIC_ACQUIRE, "agent");
            if (og + 1u == (gen + 1u) * nx) xb_add(&bar[XB_TOPGEN], 1u);
            else XB_SPIN(xb_ld(&bar[XB_TOPGEN]) == gen, bar);
        } else {
            __builtin_amdgcn_fence(__ATOMIC_ACQUIRE, "agent");
            XB_SPIN(xb_ld(&bar[XB_TOPGEN]) == gen, bar);
        }
        asm volatile("s_waitcnt vmcnt(0)" ::: "memory");
    }
    __syncthreads();
}

struct Args { const float* in[N_IN]; float* out; unsigned char* ws; int ph_lo, ph_hi; };
struct Frame {
    LAS unsigned char* lds;
    volatile LAS unsigned* MISC;
    int tid, lane, wave, vcu, G;
    unsigned char* ws; float* out;
};
#define WSP(T, off) ((T*)(F.ws + (off)))

__device__ __forceinline__ void p0_transpose_item(const float* W, int ldw, int K, bf16* WT, int mode, int nblk, LAS float* scr, int item, int lane, int ldt = 0) {
    if (ldt == 0) ldt = K;
    asm volatile("" : "+v"(lane));
    const int kb = item / nblk, nb = item % nblk, k0 = 64 * kb, n0 = 32 * nb;
    { float wv[32];
      const float* wp = W + (size_t)(k0 + (lane >> 5)) * ldw + n0 + (lane & 31);
#pragma unroll
      for (int i = 0; i < 32; ++i) wv[i] = wp[(size_t)(2 * i) * ldw];
#pragma unroll
      for (int i = 0; i < 32; ++i) scr[(2 * i + (lane >> 5)) * 33 + (lane & 31)] = wv[i]; }
    LDS_WAIT(); asm volatile("" ::: "memory");
    const int c = lane & 7;
    const int r0 = (mode == 0) ? n0 : (256 * (n0 >> 7) + (n0 & 127) + (mode == 2 ? 128 : 0));
#pragma unroll
    for (int j = 0; j < 4; ++j) { const int n = (lane >> 3) + 8 * j; const LAS float* s = scr + (8 * c) * 33 + n;
        v4u o; o.x = pk2(s[0 * 33], s[1 * 33]); o.y = pk2(s[2 * 33], s[3 * 33]); o.z = pk2(s[4 * 33], s[5 * 33]); o.w = pk2(s[6 * 33], s[7 * 33]);
        *(GAS v4u*)(WT + (size_t)(r0 + n) * ldt + k0 + 8 * c) = o; }
    LDS_WAIT(); asm volatile("" ::: "memory");
}
__device__ __forceinline__ const float* xrow(const Args& a, int r) { return r < NP ? a.in[I_XP] + (size_t)r * D : a.in[I_XS] + (size_t)(r - NP) * D; }

template <int MODE, bool GATES, int TSRC = 0>
__device__ __forceinline__ void rowwise(Frame& F, const Args& a, const bf16* RES, const bf16* T, const float* gpost, float sc, const float* gpre, bf16* Hout, bf16* XN, float* Yout, int nslab = 0, const bf16* PUP = nullptr) {
    const int gw = F.vcu * NWAVES + F.wave, NGW = F.G * NWAVES, lane = F.lane;
    const LAS f32x4* wgL = (const LAS f32x4*)F.lds;
    f32x4 gpo[8], gpr[8];
#pragma unroll
    for (int j = 0; j < 8; ++j) { gpo[j] = (MODE != 0) ? ((const GAS f32x4*)gpost)[lane + 64 * j] : (f32x4){0.f, 0.f, 0.f, 0.f}; gpr[j] = (MODE != 2) ? ((const GAS f32x4*)gpre)[lane + 64 * j] : (f32x4){0.f, 0.f, 0.f, 0.f}; }
    v2u rpre[8], tpre[8];
#define RW_PREF(r_) do { if (RES) { const GAS v2u* rp_ = (const GAS v2u*)(RES + (size_t)(r_) * D) + lane; _Pragma("unroll") for (int j = 0; j < 8; ++j) rpre[j] = rp_[64 * j]; } \
        if (MODE != 0) { const GAS v2u* tp_ = (const GAS v2u*)(T + (size_t)(r_) * D) + lane; _Pragma("unroll") for (int j = 0; j < 8; ++j) tpre[j] = tp_[64 * j]; } } while (0)
    if (gw < NP) RW_PREF(gw);
    for (int r = gw; r < M; r += NGW) {
        const bool pf = r < NP;
        f32x4 v[8]; v2u tcur[8];
        if (RES) { const GAS v2u* rp = (const GAS v2u*)(RES + (size_t)r * D) + lane;
#pragma unroll
            for (int j = 0; j < 8; ++j) { const v2u w = pf ? rpre[j] : rp[64 * j]; v[j] = (f32x4){bflo(w.x), bfhi(w.x), bflo(w.y), bfhi(w.y)}; } }
        else { const GAS f32x4* rp = (const GAS f32x4*)xrow(a, r) + lane;
#pragma unroll
            for (int j = 0; j < 8; ++j) v[j] = rp[64 * j]; }
        if (MODE != 0 && pf) {
#pragma unroll
            for (int j = 0; j < 8; ++j) tcur[j] = tpre[j]; }
        { const int rn = r + NGW; if (rn < NP) RW_PREF(rn); }
        if (MODE != 0) {
            const GAS v2u* tp = (const GAS v2u*)(T + (size_t)r * D) + lane;
            f32x4 t[8]; float ss = 0.f;
            if (TSRC != 0 && r >= NP) {
                const GAS f32x4* sp = (const GAS f32x4*)(WSP(float, WS_SLAB) + (size_t)(r - NP) * D) + lane;
#pragma unroll
                for (int j = 0; j < 8; ++j) t[j] = sp[64 * j];
                _Pragma("unroll 1") for (int s = 1; s < nslab; ++s) { sp += (size_t)NS * D / 4;
#pragma unroll
                    for (int j = 0; j < 8; ++j) t[j] += sp[64 * j]; }
                if (TSRC == 2) { const GAS v2u* pp = (const GAS v2u*)(PUP + (size_t)r * D) + lane;
#pragma unroll
                    for (int j = 0; j < 8; ++j) { const v2u pw = pp[64 * j]; const f32x4 p = (f32x4){bflo(pw.x), bfhi(pw.x), bflo(pw.y), bfhi(pw.y)}; t[j] = (f32x4){sigmf(t[j][0]), sigmf(t[j][1]), sigmf(t[j][2]), sigmf(t[j][3])} * p; } }
#pragma unroll
                for (int j = 0; j < 8; ++j) ss += dot4(t[j], t[j]);
            } else {
#pragma unroll
                for (int j = 0; j < 8; ++j) { const v2u tw = pf ? tcur[j] : tp[64 * j]; t[j] = (f32x4){bflo(tw.x), bfhi(tw.x), bflo(tw.y), bfhi(tw.y)}; ss += dot4(t[j], t[j]); }
            }
            ss = wave_sum(ss);
            const float rs = sc * (1.0f / sqrtf(ss * (1.0f / D) + EPS));
#pragma unroll
            for (int j = 0; j < 8; ++j) { const f32x4 g = gpo[j]; v[j] = v[j] + (t[j] * rs) * g;
                if (MODE == 2) ((GAS f32x4*)(Yout + (size_t)r * D))[lane + 64 * j] = v[j];
                else { v2u w; w.x = pk2(v[j][0], v[j][1]); w.y = pk2(v[j][2], v[j][3]); ((GAS v2u*)(Hout + (size_t)r * D))[lane + 64 * j] = w;
                       v[j] = (f32x4){bflo(w.x), bfhi(w.x), bflo(w.y), bfhi(w.y)}; } }
        }
        if (MODE != 2) {
            float ss = 0.f;
#pragma unroll
            for (int j = 0; j < 8; ++j) ss += dot4(v[j], v[j]);
            ss = wave_sum(ss);
            const float rs = 1.0f / sqrtf(ss * (1.0f / D) + EPS);
            float ga[8];
#pragma unroll
            for (int c = 0; c < 8; ++c) ga[c] = 0.f;
            GAS v2u* op = (GAS v2u*)(XN + (size_t)r * D) + lane;
#pragma unroll
            for (int j = 0; j < 8; ++j) { const f32x4 g = gpr[j]; const f32x4 xn = (v[j] * rs) * g;
                v2u w; w.x = pk2(xn[0], xn[1]); w.y = pk2(xn[2], xn[3]); op[64 * j] = w;
 }
        }
    }
}

constexpr int IT_FG = (D / 64) * (FF / 32), IT_FD = (FF / 64) * (D / 32), IT_INA = (D / 64) * (6144 / 32), IT_INB = (D / 64) * (8192 / 32), IT_SQ = (D / 64) * (D / 32), IT_PU = (DPLE / 64) * (D / 32);
constexpr int NITEMS_EARLY = 2 * IT_FG + IT_FD + IT_INA + IT_INB;
constexpr int NITEMS_LATE = 4 * IT_SQ + IT_PU + 2 * IT_FG + IT_FD;
__device__ __forceinline__ void transpose_early(const Args& a, Frame& F, LAS float* scr, int r) {
    bf16 *W1 = WSP(bf16, WS_W1), *W1D = WSP(bf16, WS_W1D), *WIN = WSP(bf16, WS_WIN);
    if (r < IT_FG) { p0_transpose_item(a.in[I_W1G], FF, D, W1, 1, FF / 32, scr, r, F.lane); return; } r -= IT_FG;
    if (r < IT_FG) { p0_transpose_item(a.in[I_W1U], FF, D, W1, 2, FF / 32, scr, r, F.lane); return; } r -= IT_FG;
    if (r < IT_FD) { p0_transpose_item(a.in[I_W1D], D, FF, W1D, 0, D / 32, scr, r, F.lane); return; } r -= IT_FD;
    if (r < IT_INA) { p0_transpose_item(a.in[I_WIN], 14344, D, WIN, 0, 6144 / 32, scr, r, F.lane); return; } r -= IT_INA;
    p0_transpose_item(a.in[I_WIN] + 6152, 14344, D, WIN + (size_t)6144 * D, 0, 8192 / 32, scr, r, F.lane);
}
__device__ __forceinline__ void transpose_late(const Args& a, Frame& F, LAS float* scr, int r) {
    bf16 *WAB = WSP(bf16, WS_WAB), *WO = WSP(bf16, WS_WO), *WPG = WSP(bf16, WS_WPG), *WPU = WSP(bf16, WS_WPU), *W2 = WSP(bf16, WS_W2), *W2D = WSP(bf16, WS_W2D);
    if (r < IT_SQ) { p0_transpose_item(a.in[I_WAOUT], D, D, WAB, 0, D / 32, scr, r, F.lane, 2 * D); return; } r -= IT_SQ;
    if (r < IT_SQ) { p0_transpose_item(a.in[I_WBOUT], D, D, WAB + D, 0, D / 32, scr, r, F.lane, 2 * D); return; } r -= IT_SQ;
    if (r < IT_SQ) { p0_transpose_item(a.in[I_WO], D, D, WO, 0, D / 32, scr, r, F.lane); return; } r -= IT_SQ;
    if (r < IT_SQ) { p0_transpose_item(a.in[I_WPG], D, D, WPG, 0, D / 32, scr, r, F.lane); return; } r -= IT_SQ;
    if (r < IT_PU) { p0_transpose_item(a.in[I_WPU], D, DPLE, WPU, 0, D / 32, scr, r, F.lane); return; } r -= IT_PU;
    if (r < IT_FG) { p0_transpose_item(a.in[I_W2G], FF, D, W2, 1, FF / 32, scr, r, F.lane); return; } r -= IT_FG;
    if (r < IT_FG) { p0_transpose_item(a.in[I_W2U], FF, D, W2, 2, FF / 32, scr, r, F.lane); return; } r -= IT_FG;
    p0_transpose_item(a.in[I_W2D], D, FF, W2D, 0, D / 32, scr, r, F.lane);
}
template <bool LATE = false>
__device__ __forceinline__ void transpose_tail(Frame& F, const Args& a, int bx, int lo, int first, int count) {
    if (F.G != 256 || bx < lo) return;
    LAS float* scr = (LAS float*)(F.lds + F.wave * 16384);
    for (int j = (bx - lo) * NWAVES + F.wave; j < count; j += (F.G - lo) * NWAVES) { if (LATE) transpose_late(a, F, scr, first + j); else transpose_early(a, F, scr, first + j); }
}
__device__ __forceinline__ void p0_prologue(Frame& F, const Args& a) {
    LAS float* scr = (LAS float*)(F.lds + F.wave * 16384);
    const int gw = F.vcu * NWAVES + F.wave, NGW = F.G * NWAVES;
    for (int it = gw; it < (F.G == 256 ? 2 * IT_FG : NITEMS_EARLY); it += NGW) transpose_early(a, F, scr, it);
    { bf16* WG = WSP(bf16, WS_WIN) + (size_t)NZ * D; const int gt = F.vcu * (NWAVES * 64) + F.tid, NT = F.G * NWAVES * 64;
      for (int i = gt; i < 256 * D; i += NT) { const int c = i >> 11, k = i & (D - 1); WG[i] = c < 8 ? (bf16)f2bf(a.in[I_WIN][(size_t)k * 14344 + 6144 + c]) : (bf16)0; } }
    { bf16* PB = WSP(bf16, WS_PB);
      for (int r = gw; r < M; r += NGW) { const float* pr = r < NP ? a.in[I_PP] + (size_t)r * DPLE : a.in[I_PS] + (size_t)(r - NP) * DPLE;
          const f32x4 v = ((const GAS f32x4*)pr)[F.lane]; v2u w; w.x = pk2(v[0], v[1]); w.y = pk2(v[2], v[3]); ((GAS v2u*)(PB + (size_t)r * DPLE))[F.lane] = w; } }
    rowwise<0, false>(F, a, nullptr, nullptr, nullptr, 0.f, a.in[I_G1PRE], nullptr, WSP(bf16, WS_XN), nullptr);
}

__device__ __forceinline__ void conv_silu_all(Frame& F, const Args& a) {
    const bf16* Z0 = WSP(bf16, WS_Z); bf16* QC = WSP(bf16, WS_QC); bf16* KC = WSP(bf16, WS_KC);
    const float* wc = a.in[I_WCONV]; const float* bc = a.in[I_BCONV]; const float* sconv = a.in[I_SCONV];
    const int gt = F.vcu * (NWAVES * 64) + F.tid, NT = F.G * NWAVES * 64;
    for (int it = gt + NP * 256; it < M * 256; it += NT) {
        const int r = it >> 8, col = (it & 255) * 8;
        float y[8];
        { const f32x4 b0 = *(const GAS f32x4*)(bc + col), b1 = *(const GAS f32x4*)(bc + col + 4);
          y[0] = b0[0]; y[1] = b0[1]; y[2] = b0[2]; y[3] = b0[3]; y[4] = b1[0]; y[5] = b1[1]; y[6] = b1[2]; y[7] = b1[3]; }
        int t, bsm = 0;
        if (r < NP) t = r & (SEQ - 1); else { const int s = r - NP; bsm = s >> 2; t = s & 3; }
#pragma unroll
        for (int j = 0; j < 4; ++j) {
            const int tt = t - 3 + j;
            float x[8]; bool have = true;
            if (tt >= 0) { const v4u w = *(const GAS v4u*)(Z0 + (size_t)(r - 3 + j) * D + col);
                x[0] = bflo(w.x); x[1] = bfhi(w.x); x[2] = bflo(w.y); x[3] = bfhi(w.y); x[4] = bflo(w.z); x[5] = bfhi(w.z); x[6] = bflo(w.w); x[7] = bfhi(w.w); }
            else if (r >= NP) { const float* sp = sconv + (size_t)(bsm * 3 + (tt + 3)) * D + col; const f32x4 s0 = *(const GAS f32x4*)sp, s1 = *(const GAS f32x4*)(sp + 4);
                x[0] = s0[0]; x[1] = s0[1]; x[2] = s0[2]; x[3] = s0[3]; x[4] = s1[0]; x[5] = s1[1]; x[6] = s1[2]; x[7] = s1[3]; }
            else have = false;
            if (have) { const f32x4 w0 = *(const GAS f32x4*)(wc + (size_t)j * D + col), w1 = *(const GAS f32x4*)(wc + (size_t)j * D + col + 4);
                y[0] += w0[0] * x[0]; y[1] += w0[1] * x[1]; y[2] += w0[2] * x[2]; y[3] += w0[3] * x[3]; y[4] += w1[0] * x[4]; y[5] += w1[1] * x[5]; y[6] += w1[2] * x[6]; y[7] += w1[3] * x[7]; }
        }
        const float scl = col >= 1024 ? 0.0625f : 1.0f;
#pragma unroll
        for (int e = 0; e < 8; ++e) y[e] = y[e] * sigmf(y[e]) * scl;
        v4u o; o.x = pk2(y[0], y[1]); o.y = pk2(y[2], y[3]); o.z = pk2(y[4], y[5]); o.w = pk2(y[6], y[7]);
        bf16* dst = col < 1024 ? QC + (size_t)r * 1024 + col : KC + (size_t)r * 1024 + (col - 1024);
        *(GAS v4u*)dst = o;
    }
}
__device__ __forceinline__ bf16x8 ldfrag(const LAS bf16* base, int row0, int ld, int k0, int lane) { return *(const LAS bf16x8*)(base + (row0 + (lane & 15)) * ld + k0 + 8 * (lane >> 4)); }
__device__ __forceinline__ bf16x8 ldfrag_t(const LAS bf16* base, int k0, int ld, int c0, int lane) {
    const LAS bf16* p = base + (k0 + 8 * (lane >> 4)) * ld + c0 + (lane & 15); bf16x8 r;
#pragma unroll
    for (int j = 0; j < 8; ++j) r[j] = (short)p[j * ld];
    return r;
}
#define MFMA16(a, b, c) __builtin_amdgcn_mfma_f32_16x16x32_bf16((a), (b), (c), 0, 0, 0)

constexpr int GM_LD = 136, GM_X = 0, GM_W = 128 * GM_LD * 2, GM_F = 2 * 128 * GM_LD * 2;
__device__ __forceinline__ void gmlp_prompt_unit(Frame& F, const Args& a, int b, int n, int g) {
    const int tid = F.tid, lane = F.lane, wave = F.wave;
    LAS bf16* Xs = (LAS bf16*)(F.lds + GM_X); LAS bf16* Ws = (LAS bf16*)(F.lds + GM_W);
    LAS float* mu = (LAS float*)(F.lds + GM_F); LAS float* rs = mu + 128; LAS float* alpha = mu + 256; LAS float* beta = mu + 384;
    const bf16* Z3 = WSP(bf16, WS_Z) + (size_t)3 * M * D; const bf16* Z4 = WSP(bf16, WS_Z) + (size_t)4 * M * D; bf16* HB = WSP(bf16, WS_AB) + D;
    const float* STAT = WSP(float, WS_STAT);
    const size_t r0 = (size_t)b * SEQ + (size_t)n * 128;
    if (tid < 128) { const GAS f32x4* sp = (const GAS f32x4*)(STAT + (r0 + tid) * 64); float s1 = 0.f, s2 = 0.f;
#pragma unroll
        for (int i = 0; i < 16; ++i) { const f32x4 v = sp[i]; s1 += v[0] + v[2]; s2 += v[1] + v[3]; }
        const float m_ = s1 * (1.0f / D), var = fmaxf(s2 * (1.0f / D) - m_ * m_, 0.f); mu[tid] = m_; rs[tid] = 1.0f / sqrtf(var + EPS); }
    __syncthreads();
    { const int t = tid >> 2, q = tid & 3; const float* wrow = a.in[I_WSP] + ((size_t)(g * 128 + t)) * 128 + 32 * q; float al = 0.f, be = 0.f;
#pragma unroll
      for (int i = 0; i < 8; ++i) { const f32x4 w = *(const GAS f32x4*)(wrow + 4 * i); float wp[4];
#pragma unroll
          for (int e = 0; e < 4; ++e) { const int s = 32 * q + 4 * i + e; const float wv = (s <= t) ? w[e] : 0.f; wp[e] = bflo(f2bf(wv * rs[s])); al += wp[e] * mu[s]; be += wv; }
          v2u o; o.x = pk2(wp[0], wp[1]); o.y = pk2(wp[2], wp[3]); *(LAS v2u*)(Ws + t * GM_LD + 32 * q + 4 * i) = o; }
      al += __shfl_xor(al, 1); al += __shfl_xor(al, 2); be += __shfl_xor(be, 1); be += __shfl_xor(be, 2);
      if (q == 0) { alpha[t] = al; beta[t] = be; } }
    v4u xn[4];
#define GM_LDX(cs_) do { const int cb_ = g * 512 + (cs_) * 128; _Pragma("unroll") for (int i = 0; i < 4; ++i) { const int ch = tid + 512 * i, row = ch >> 4, cc = ch & 15; \
        xn[i] = *(const GAS v4u*)(Z4 + (r0 + row) * D + cb_ + cc * 8); } } while (0)
    GM_LDX(0);
    for (int cs = 0; cs < 4; ++cs) {
        const int cbase = g * 512 + cs * 128;
#pragma unroll
        for (int i = 0; i < 4; ++i) { const int ch = tid + 512 * i, row = ch >> 4, cc = ch & 15; *(LAS v4u*)(Xs + row * GM_LD + cc * 8) = xn[i]; }
        __syncthreads();
        if (cs + 1 < 4) GM_LDX(cs + 1);
        const int cg = cbase + 16 * wave + 4 * (lane >> 4);
        v2u uw[8]; float bs[8];
#pragma unroll
        for (int ti = 0; ti < 8; ++ti) { const int t = ti * 16 + (lane & 15); uw[ti] = *(const GAS v2u*)(Z3 + (r0 + t) * D + cg); bs[ti] = a.in[I_BSP][g * 128 + t]; }
        const f32x4 gl = *(const GAS f32x4*)(a.in[I_GLN] + cg), bl = *(const GAS f32x4*)(a.in[I_BLN] + cg);
        f32x4 acc[8];
#pragma unroll
        for (int ti = 0; ti < 8; ++ti) acc[ti] = (f32x4){0.f, 0.f, 0.f, 0.f};
#pragma unroll
        for (int ks = 0; ks < 4; ++ks) { const bf16x8 af = ldfrag_t(Xs, ks * 32, GM_LD, 16 * wave, lane);
#pragma unroll
            for (int ti = 0; ti < 8; ++ti) if (ks <= (ti >> 1)) { const bf16x8 bfr = ldfrag(Ws, ti * 16, GM_LD, ks * 32, lane); acc[ti] = MFMA16(af, bfr, acc[ti]); } }
#pragma unroll
        for (int ti = 0; ti < 8; ++ti) { const int t = ti * 16 + (lane & 15); const float al = alpha[t], be = beta[t];
            const f32x4 u = (f32x4){bflo(uw[ti].x), bfhi(uw[ti].x), bflo(uw[ti].y), bfhi(uw[ti].y)};
            const f32x4 o = (gl * (acc[ti] - al) + bl * be + bs[ti]) * u;
            v2u w; w.x = pk2(o[0], o[1]); w.y = pk2(o[2], o[3]); *(GAS v2u*)(HB + (r0 + t) * (2 * D) + cg) = w; }
        __syncthreads();
    }
#undef GM_LDX
}
__device__ __forceinline__ void gmlp_sample_items(Frame& F, const Args& a, int it0, int it1, int step) {
    const int lane = F.lane;
    const bf16* Z3 = WSP(bf16, WS_Z) + (size_t)3 * M * D; const bf16* Z4 = WSP(bf16, WS_Z) + (size_t)4 * M * D; bf16* HB = WSP(bf16, WS_AB) + D;
    const float* STAT = WSP(float, WS_STAT); float* VS = F.out + O_VS;
    for (int it = it0; it < it1; it += step) {
        const int b = it >> 2, g = it & 3, c = g * 512 + lane * 8;
        float gl[8], bl[8];
        { const f32x4 g0 = *(const GAS f32x4*)(a.in[I_GLN] + c), g1 = *(const GAS f32x4*)(a.in[I_GLN] + c + 4), b0 = *(const GAS f32x4*)(a.in[I_BLN] + c), b1 = *(const GAS f32x4*)(a.in[I_BLN] + c + 4);
#pragma unroll
          for (int e = 0; e < 4; ++e) { gl[e] = g0[e]; gl[4 + e] = g1[e]; bl[e] = b0[e]; bl[4 + e] = b1[e]; } }
        float vg[4][8];
#pragma unroll
        for (int t = 0; t < 4; ++t) { const size_t row = (size_t)NP + 4 * b + t;
            float s1 = lane < 32 ? STAT[(row * 32 + lane) * 2] : 0.f, s2 = lane < 32 ? STAT[(row * 32 + lane) * 2 + 1] : 0.f; s1 = wave_sum(s1); s2 = wave_sum(s2);
            const float m_ = s1 * (1.0f / D), var = fmaxf(s2 * (1.0f / D) - m_ * m_, 0.f), rs = 1.0f / sqrtf(var + EPS);
            const v4u w = *(const GAS v4u*)(Z4 + row * D + c); float x[8] = {bflo(w.x), bfhi(w.x), bflo(w.y), bfhi(w.y), bflo(w.z), bfhi(w.z), bflo(w.w), bfhi(w.w)};
#pragma unroll
            for (int e = 0; e < 8; ++e) vg[t][e] = (x[e] - m_) * rs * gl[e] + bl[e];
            float* vo = VS + ((size_t)(4 * b + t)) * D + c;
            *(GAS f32x4*)vo = (f32x4){vg[t][0], vg[t][1], vg[t][2], vg[t][3]}; *(GAS f32x4*)(vo + 4) = (f32x4){vg[t][4], vg[t][5], vg[t][6], vg[t][7]}; }
#pragma unroll
        for (int t = 0; t < 4; ++t) { const size_t row = (size_t)NP + 4 * b + t; float o[8]; const float bs = a.in[I_BSP][g * 128 + t];
#pragma unroll
            for (int e = 0; e < 8; ++e) o[e] = bs;
#pragma unroll
            for (int s = 0; s < 4; ++s) if (s <= t) { const float w = a.in[I_WSP][((size_t)(g * 128 + t)) * 128 + s];
#pragma unroll
                for (int e = 0; e < 8; ++e) o[e] += w * vg[s][e]; }
            const v4u uw = *(const GAS v4u*)(Z3 + row * D + c); const float u[8] = {bflo(uw.x), bfhi(uw.x), bflo(uw.y), bfhi(uw.y), bflo(uw.z), bfhi(uw.z), bflo(uw.w), bfhi(uw.w)};
            v4u w; w.x = pk2(o[0] * u[0], o[1] * u[1]); w.y = pk2(o[2] * u[2], o[3] * u[3]); w.z = pk2(o[4] * u[4], o[5] * u[5]); w.w = pk2(o[6] * u[6], o[7] * u[7]);
            *(GAS v4u*)(HB + row * (2 * D) + c) = w; }
    }
}

__device__ __forceinline__ void mlstm_scalar_table_wg(Frame& F, int bh) {
    const int lane = F.lane, wave = F.wave, b = bh >> 2, h = bh & 3;
    const float* GT = WSP(float, WS_GATES); float* SCT = WSP(float, WS_SCT) + (size_t)bh * 32 * 384;
    LAS float* B63 = (LAS float*)F.lds; LAS float* P63 = B63 + 32; LAS float* MC = B63 + 64; LAS float* M63 = B63 + 96;
    float as[4], pm[4], bc[4];
#pragma unroll
    for (int i = 0; i < 4; ++i) { const int c = 4 * wave + i; const size_t r = (size_t)b * SEQ + (size_t)c * 64 + lane;
        const float ig = GT[r * 8 + h], lf = GT[r * 8 + 4 + h];
        float s = lf;
#pragma unroll
        for (int o = 1; o < 64; o <<= 1) { const float t = __shfl_up(s, o); if (lane >= o) s += t; }
        bc[i] = s; as[i] = ig - s; float p = as[i];
#pragma unroll
        for (int o = 1; o < 64; o <<= 1) { const float t = __shfl_up(p, o); if (lane >= o) p = fmaxf(p, t); }
        pm[i] = p;
        if (lane == 63) { B63[c] = s; P63[c] = p; } }
    __syncthreads();
    if (F.tid == 0) { float m = 0.f;
        for (int c = 0; c < 32; ++c) { MC[c] = m; const float mm = fmaxf(m, P63[c]); M63[c] = mm; m = B63[c] + mm; } }
    __syncthreads();
#pragma unroll
    for (int i = 0; i < 4; ++i) { const int c = 4 * wave + i; float* sc = SCT + c * 384; const float m_c = MC[c], m63 = M63[c], Mt = fmaxf(m_c, pm[i]);
        const float Ac = P63[c];
        sc[lane] = __expf(as[i] - Ac); sc[64 + lane] = __expf(Ac - Mt); sc[128 + lane] = __expf(m_c - Mt); sc[192 + lane] = __expf(-(bc[i] + Mt)); sc[256 + lane] = __expf(as[i] - m63);
        if (lane == 0) { sc[320] = __expf(m_c - m63); sc[321] = B63[c] + m63; } }
    __syncthreads();
}
typedef short s16x4 __attribute__((ext_vector_type(4)));
constexpr int CH_LDQ = 272, CH_LDV = 144, CH_LDSS = 80;
constexpr int CH_Q = 0, CH_K = CH_Q + 64 * CH_LDQ * 2, CH_V = CH_K + 64 * CH_LDQ * 2, CH_WV = CH_V + 64 * CH_LDV * 2, CH_S = CH_WV + 64 * CH_LDV * 2, CH_N = CH_S + 64 * CH_LDSS * 2,
              CH_SC = CH_N + 2048, CH_QN = CH_SC + 2 * 384 * 4, CH_END = CH_QN + 256;
static_assert(CH_END <= LDS_PHASE_BYTES, "chain LDS");
__device__ __forceinline__ bf16x8 ldfrag_tr(const LAS bf16* base, int k0, int ld, int c0, int lane) {
    const int g = lane >> 4, q = (lane & 15) >> 2, p = lane & 3;
    const LAS bf16* a0 = base + (k0 + 8 * g + q) * ld + c0 + 4 * p;
    const s16x4 lo = __builtin_amdgcn_ds_read_tr16_b64_v4i16((LAS s16x4*)a0), hi = __builtin_amdgcn_ds_read_tr16_b64_v4i16((LAS s16x4*)(a0 + 4 * ld));
    return (bf16x8){lo[0], lo[1], lo[2], lo[3], hi[0], hi[1], hi[2], hi[3]};
}
#define CH_PIN2(a_, b_) asm volatile("" : "+v"(a_), "+v"(b_) :: "memory")
#define CH_PIN4(a_, b_, c_, d_) asm volatile("" : "+v"(a_), "+v"(b_), "+v"(c_), "+v"(d_) :: "memory")
#define CH_BAR() do { asm volatile("s_waitcnt lgkmcnt(0)" ::: "memory"); __builtin_amdgcn_s_barrier(); asm volatile("" ::: "memory"); } while (0)
__device__ __forceinline__ v4u pk8(f32x4 a, f32x4 b) { v4u w; w.x = pg8::cvt_pk_bf16(a[0], a[1]); w.y = pg8::cvt_pk_bf16(a[2], a[3]); w.z = pg8::cvt_pk_bf16(b[0], b[1]); w.w = pg8::cvt_pk_bf16(b[2], b[3]); return w; }
constexpr int SR_LD = 264;
__device__ __forceinline__ void sraw_item(Frame& F, const Args& a, int bh, int c) {
    const int tid = F.tid, lane = F.lane, wave = F.wave, b = bh >> 2, h = bh & 3, lq = lane >> 4, lc = lane & 15;
    LAS bf16* Qs = (LAS bf16*)F.lds; LAS bf16* Ks = Qs + 64 * SR_LD;
    const bf16* Z0 = WSP(bf16, WS_Z); bf16* QC = WSP(bf16, WS_QC); bf16* KC = WSP(bf16, WS_KC); bf16* SRAW = WSP(bf16, WS_SRAW) + (size_t)(bh * 32 + c) * 4096;
    const float* wc = a.in[I_WCONV]; const float* bc = a.in[I_BCONV];
    const size_t r0 = (size_t)b * SEQ + (size_t)c * 64;
    { const int cg = tid & 63, isk = cg >> 5, cl = (cg & 31) * 8, col = (isk ? 1024 : 0) + h * 256 + cl;
      float wj[4][8], bj[8];
      { const f32x4 b0 = *(const GAS f32x4*)(bc + col), b1 = *(const GAS f32x4*)(bc + col + 4);
#pragma unroll
        for (int e = 0; e < 4; ++e) { bj[e] = b0[e]; bj[4 + e] = b1[e]; }
#pragma unroll
        for (int j = 0; j < 4; ++j) { const f32x4 w0 = *(const GAS f32x4*)(wc + (size_t)j * D + col), w1 = *(const GAS f32x4*)(wc + (size_t)j * D + col + 4);
#pragma unroll
            for (int e = 0; e < 4; ++e) { wj[j][e] = w0[e]; wj[j][4 + e] = w1[e]; } } }
      const float scl = isk ? 0.0625f : 1.0f;
      v4u tw[8][4];
#pragma unroll
      for (int i = 0; i < 8; ++i) { const int row = (tid >> 6) + 8 * i, t = c * 64 + row;
#pragma unroll
          for (int j = 0; j < 4; ++j) { tw[i][j] = (v4u){0u, 0u, 0u, 0u}; if (t - 3 + j >= 0) tw[i][j] = *(const GAS v4u*)(Z0 + (r0 + row - 3 + j) * D + col); } }
      asm volatile("" ::: "memory");
#pragma unroll
      for (int i = 0; i < 8; ++i) { const int row = (tid >> 6) + 8 * i; float y[8];
#pragma unroll
          for (int e = 0; e < 8; ++e) y[e] = bj[e];
#pragma unroll
          for (int j = 0; j < 4; ++j) { const v4u w = tw[i][j];
                  const float x[8] = {bflo(w.x), bfhi(w.x), bflo(w.y), bfhi(w.y), bflo(w.z), bfhi(w.z), bflo(w.w), bfhi(w.w)};
#pragma unroll
                  for (int e = 0; e < 8; ++e) y[e] += wj[j][e] * x[e]; }
#pragma unroll
          for (int e = 0; e < 8; ++e) y[e] = y[e] * sigmf(y[e]) * scl;
          v4u o; o.x = pk2(y[0], y[1]); o.y = pk2(y[2], y[3]); o.z = pk2(y[4], y[5]); o.w = pk2(y[6], y[7]);
          if (isk) *(GAS v4u*)(KC + (r0 + row) * 1024 + h * 256 + cl) = o;
          else { bf16* qd = QC + (r0 + row) * 1024 + h * 256 + (cl & ~31) + ((cl & 15) >> 2) * 8 + ((cl >> 4) & 1) * 4;
              *(GAS v2u*)qd = (v2u){o.x, o.y}; *(GAS v2u*)(qd + 8) = (v2u){o.z, o.w}; }
          *(LAS v4u*)((isk ? Ks : Qs) + row * SR_LD + cl) = o; } }
    __syncthreads();
#pragma unroll
    for (int q = 0; q < 2; ++q) { const int tt = wave + 8 * q, si = tt >> 2, ti = tt & 3, s0 = si * 16, t0 = ti * 16;
        v2u o = (v2u){0u, 0u};
        if (si <= ti) { f32x4 acc = (f32x4){0.f, 0.f, 0.f, 0.f};
#pragma unroll
            for (int ks = 0; ks < 8; ++ks) acc = MFMA16(ldfrag(Ks, s0, SR_LD, ks * 32, lane), ldfrag(Qs, t0, SR_LD, ks * 32, lane), acc);
            const int t = t0 + lc;
#pragma unroll
            for (int j = 0; j < 4; ++j) { const int s = s0 + 4 * lq + j; if (s > t) acc[j] = 0.f; }
            o.x = pk2(acc[0], acc[1]); o.y = pk2(acc[2], acc[3]); }
        *(GAS v2u*)(SRAW + (t0 + lc) * 64 + s0 + 4 * lq) = o; }
    __syncthreads();
}
__device__ __forceinline__ bf16x8 scale8(bf16x8 v, f32x4 e0, f32x4 e1) {
    const v4u a = __builtin_bit_cast(v4u, v); v4u o;
    o.x = pg8::cvt_pk_bf16(bflo(a.x) * e0[0], bfhi(a.x) * e0[1]); o.y = pg8::cvt_pk_bf16(bflo(a.y) * e0[2], bfhi(a.y) * e0[3]);
    o.z = pg8::cvt_pk_bf16(bflo(a.z) * e1[0], bfhi(a.z) * e1[1]); o.w = pg8::cvt_pk_bf16(bflo(a.w) * e1[2], bfhi(a.w) * e1[3]);
    return __builtin_bit_cast(bf16x8, o);
}
constexpr int CH5_Q = 0, CH5_K = 65536, CH5_V = 131072, CH5_N = CH5_V + 16384, CH5_SC = CH5_N + 2048, CH5_NB = CH5_SC + 2 * 384 * 4, CH5_END = CH5_NB + 2 * 512;
static_assert(CH5_END <= LDS_PHASE_BYTES, "chain LDS");
__device__ __forceinline__ int ch_swz(int row) { return ((row & 3) << 1) | (((row >> 3) & 1) << 3); }
#define CH_TR(dst_, addr_, off_) asm volatile("ds_read_b64_tr_b16 %0, %1 offset:%2" : "=v"(dst_) : "v"(addr_), "n"(off_) : "memory")
#define CH_LGKM4(n_, a_, b_, c_, d_) asm volatile("s_waitcnt lgkmcnt(%4)" : "+v"(a_), "+v"(b_), "+v"(c_), "+v"(d_) : "n"(n_) : "memory")
__device__ __forceinline__ bf16x8 ch_cat(v2u lo, v2u hi) { return __builtin_bit_cast(bf16x8, (v4u){lo.x, lo.y, hi.x, hi.y}); }
__device__ __forceinline__ void mlstm_chain_unit(Frame& F, const Args& a, int bh, int slice) {
    const int tid = F.tid, lane = F.lane, wave = F.wave, wv = __builtin_amdgcn_readfirstlane(F.wave), b = bh >> 2, h = bh & 3, lq = lane >> 4, lc = lane & 15, dvc = 16 * wv;
    LAS unsigned char* L = F.lds;
    LAS float* NV = (LAS float*)(L + CH5_N); LAS float* SC = (LAS float*)(L + CH5_SC);
    const bf16* QC = WSP(bf16, WS_QC); const bf16* KC = WSP(bf16, WS_KC); const bf16* ZV = WSP(bf16, WS_Z) + (size_t)1 * M * D; bf16* HRAW = WSP(bf16, WS_HRAW);
    const float* SCT = WSP(float, WS_SCT) + (size_t)bh * 32 * 384; const bf16* SRAW = WSP(bf16, WS_SRAW) + (size_t)bh * 32 * 4096; float* DENINV = WSP(float, WS_DENINV);
    NV[tid] = 0.f;
    if (tid < 256) ((LAS unsigned*)(L + CH5_NB))[tid] = 0u;
    f32x4 cacc[16]; const f32x4 z4 = (f32x4){0.f, 0.f, 0.f, 0.f};
#pragma unroll
    for (int i = 0; i < 16; ++i) cacc[i] = z4;
    const size_t rowbase = (size_t)b * SEQ;
    unsigned goff0; { const int row = 8 * wave + (lane >> 5), pc = lane & 31; goff0 = (unsigned)(row * 2048 + ((pc ^ ch_swz(row)) * 16)); }
    const char* gq = (const char*)(QC + rowbase * 1024 + h * 256); const char* gk = (const char*)(KC + rowbase * 1024 + h * 256);
    unsigned gvoff0; { const int s = lane, row = ((s >> 5) << 4) | ((((s >> 1) & 7) >> 2) << 3) | (((s >> 4) & 1) << 2) | ((s >> 1) & 3); gvoff0 = (unsigned)(row * (D * 2) + (s & 1) * 16); }
    const char* gv = (const char*)(ZV + rowbase * D + h * 512 + slice * 128 + dvc);
    const int svoff = lc * 128 + lq * 16;
    v4u sreg[8];
#define CH_DMA_QK(c_) do { const size_t cb_ = (size_t)(c_) * (64 * 2048); const int bo_ = ((c_) & 1) * 32768 + wv * 4096; \
        _Pragma("unroll") for (int i = 0; i < 4; ++i) { \
            const unsigned go_ = goff0 ^ ((i & 1) << 6); \
            __builtin_amdgcn_global_load_lds((const unsigned*)(gq + cb_ + i * 4096 + go_), (LAS unsigned*)(L + CH5_Q + bo_ + i * 1024), 16, 0, 0); \
            __builtin_amdgcn_global_load_lds((const unsigned*)(gk + cb_ + i * 4096 + go_), (LAS unsigned*)(L + CH5_K + bo_ + i * 1024), 16, 0, 0); } } while (0)
#define CH_DMA_V(c_) do { const size_t cb_ = (size_t)(c_) * (64 * D * 2); _Pragma("unroll") for (int i = 0; i < 2; ++i) \
        __builtin_amdgcn_global_load_lds((const unsigned*)(gv + cb_ + (size_t)i * (32 * D * 2) + gvoff0), (LAS unsigned*)(L + CH5_V + wv * 2048 + i * 1024), 16, 0, 0); } while (0)
#define CH_LD_S(c_) do { const char* sb_ = (const char*)SRAW + (size_t)(c_) * 8192; \
        asm volatile("global_load_dwordx4 %0, %4, %5\n\tglobal_load_dwordx4 %1, %4, %5 offset:64\n\tglobal_load_dwordx4 %2, %4, %5 offset:2048\n\tglobal_load_dwordx4 %3, %4, %5 offset:2112" \
            : "=&v"(sreg[0]), "=&v"(sreg[1]), "=&v"(sreg[2]), "=&v"(sreg[3]) : "v"(svoff), "s"(sb_) : "memory"); \
        asm volatile("global_load_dwordx4 %0, %4, %5\n\tglobal_load_dwordx4 %1, %4, %5 offset:64\n\tglobal_load_dwordx4 %2, %4, %5 offset:2048\n\tglobal_load_dwordx4 %3, %4, %5 offset:2112" \
            : "=&v"(sreg[4]), "=&v"(sreg[5]), "=&v"(sreg[6]), "=&v"(sreg[7]) : "v"(svoff), "s"(sb_ + 4096) : "memory"); } while (0)
#define CH_LD_SC(c_) do { if (wv == 0) { _Pragma("unroll") for (int i = 0; i < 6; ++i) \
        __builtin_amdgcn_global_load_lds((const unsigned*)(SCT + (c_) * 384 + 64 * i + lane), (LAS unsigned*)(L + CH5_SC + ((c_) & 1) * 1536 + i * 256), 4, 0, 0); } } while (0)
    const int sw = ch_swz(lc), tg = lane >> 4, tq = (lane & 15) >> 2, tp = lane & 3;
    const unsigned qb0 = (unsigned)(CH5_Q + lc * 512 + (((sw & 12) | (lq ^ (sw & 2))) << 4));
    const unsigned kb0 = (unsigned)(CH5_K + (8 * tg + tq) * 512 + (tp >> 1) * 16 + (tp & 1) * 8 + ((tq | ((tg & 1) << 2)) << 5));
    const unsigned vb0 = (unsigned)(CH5_V + wv * 2048 + ((tg >> 1) * 32 + ((tg & 1) * 4 + tq) * 2 + (tp >> 1)) * 16 + (tp & 1) * 8);
    const unsigned lbase = (unsigned)(__UINTPTR_TYPE__)L, vaddr = lbase + vb0;
    CH_LD_S(0); CH_LD_SC(0); CH_DMA_QK(0); CH_DMA_V(0);
    asm volatile("s_waitcnt vmcnt(0)" ::: "memory");
    for (int c = 0; c < SEQ / 64; ++c) {
        CH_BAR();
        CH_LD_SC(c + 1); CH_DMA_QK(c + 1);
        LAS float* sc = SC + (c & 1) * 384;
        const LAS float* NVc = NV + (c & 1) * 256; LAS float* NVn = NV + ((c + 1) & 1) * 256;
        const size_t r0 = rowbase + (size_t)c * 64;
        const unsigned qbase = qb0 + (c & 1) * 32768, kbase = kb0 + (c & 1) * 32768;
        f32x4 nacc[4], nac2[4], qacc = z4;
#pragma unroll
        for (int ti = 0; ti < 4; ++ti) { nacc[ti] = z4; nac2[ti] = z4; }
        { v4u qw[8][4];
#define CH_LDQP(ks_) do { const unsigned qa_ = (qbase ^ (((ks_) & 3) << 6)) + ((ks_) >> 2) * 256; _Pragma("unroll") for (int ti = 0; ti < 4; ++ti) qw[ks_][ti] = *(const LAS v4u*)(L + qa_ + ti * 8192); } while (0)
          CH_LDQP(0);
#pragma unroll
          for (int ks = 0; ks < 8; ++ks) {
              if (ks + 1 < 8) CH_LDQP(ks + 1);
              const bf16x8 cf = __builtin_bit_cast(bf16x8, pk8(cacc[2 * ks], cacc[2 * ks + 1]));
              CH_PIN4(qw[ks][0], qw[ks][1], qw[ks][2], qw[ks][3]);
#pragma unroll
              for (int ti = 0; ti < 4; ++ti) nacc[ti] = MFMA16(cf, __builtin_bit_cast(bf16x8, qw[ks][ti]), nacc[ti]);
          }
#undef CH_LDQP
          { const int tq_ = wv & 3, kh_ = wv >> 2; v4u qf[4], nf[4];
#pragma unroll
            for (int k4 = 0; k4 < 4; ++k4) { qf[k4] = *(const LAS v4u*)(L + ((qbase ^ (k4 << 6)) + kh_ * 256 + tq_ * 8192)); nf[k4] = *(const LAS v4u*)(L + CH5_NB + (c & 1) * 512 + kh_ * 256 + k4 * 64 + lq * 16); }
#pragma unroll
            for (int k4 = 0; k4 < 4; ++k4) qacc = MFMA16(__builtin_bit_cast(bf16x8, nf[k4]), __builtin_bit_cast(bf16x8, qf[k4]), qacc); }
        }
        float rsum[4];
        asm volatile("s_waitcnt vmcnt(20)" ::: "memory");
        v2u vt0, vt1, vt2, vt3; CH_TR(vt0, vaddr, 0); CH_TR(vt1, vaddr, 256); CH_TR(vt2, vaddr, 1024); CH_TR(vt3, vaddr, 1280);
        CH_LGKM4(0, vt0, vt1, vt2, vt3);
        const bf16x8 vfk0 = ch_cat(vt0, vt1), vfk1 = ch_cat(vt2, vt3);
        CH_DMA_V(c + 1);
        {
          const f32x4 c0 = *(const LAS f32x4*)(sc + 8 * lq), c1 = *(const LAS f32x4*)(sc + 8 * lq + 4), c2 = *(const LAS f32x4*)(sc + 32 + 8 * lq), c3 = *(const LAS f32x4*)(sc + 32 + 8 * lq + 4);
          const bf16x8 vf0 = scale8(vfk0, c0, c1), vf1 = scale8(vfk1, c2, c3);
          const bf16x8 cb0 = __builtin_bit_cast(bf16x8, pk8(c0, c1)), cb1 = __builtin_bit_cast(bf16x8, pk8(c2, c3));
          asm volatile("s_waitcnt vmcnt(14)" : "+v"(sreg[0]), "+v"(sreg[1]), "+v"(sreg[2]), "+v"(sreg[3]), "+v"(sreg[4]), "+v"(sreg[5]), "+v"(sreg[6]), "+v"(sreg[7]) :: "memory");
#pragma unroll
          for (int ti = 0; ti < 4; ++ti) { const bf16x8 sa = __builtin_bit_cast(bf16x8, sreg[2 * ti]), sb = __builtin_bit_cast(bf16x8, sreg[2 * ti + 1]);
              nac2[ti] = MFMA16(vf0, sa, nac2[ti]); nac2[ti] = MFMA16(vf1, sb, nac2[ti]);
              f32x4 ra = MFMA16(cb0, sa, z4); ra = MFMA16(cb1, sb, ra); rsum[ti] = ra[0]; } }
        { const float decay = sc[320];
          const f32x4 e0 = *(const LAS f32x4*)(sc + 256 + 8 * lq), e1 = *(const LAS f32x4*)(sc + 256 + 8 * lq + 4), e2 = *(const LAS f32x4*)(sc + 288 + 8 * lq), e3 = *(const LAS f32x4*)(sc + 288 + 8 * lq + 4);
          const bf16x8 wf0 = scale8(vfk0, e0, e1), wf1 = scale8(vfk1, e2, e3);
          const bf16x8 ef0 = __builtin_bit_cast(bf16x8, pk8(e0, e1)), ef1 = __builtin_bit_cast(bf16x8, pk8(e2, e3));
          v2u kt[16][4];
#define CH_KTR(dt_) do { const unsigned ka_ = lbase + ((kbase ^ (((dt_) & 7) << 5)) + ((dt_) >> 3) * 256); CH_TR(kt[dt_][0], ka_, 0); CH_TR(kt[dt_][1], ka_, 2048); CH_TR(kt[dt_][2], ka_, 16384); CH_TR(kt[dt_][3], ka_, 18432); } while (0)
          CH_KTR(0); CH_KTR(1);
#pragma unroll
          for (int dt = 0; dt < 16; ++dt) { if (dt + 2 < 16) CH_KTR(dt + 2);
              if (dt < 14) CH_LGKM4(8, kt[dt][0], kt[dt][1], kt[dt][2], kt[dt][3]); else if (dt == 14) CH_LGKM4(4, kt[dt][0], kt[dt][1], kt[dt][2], kt[dt][3]); else CH_LGKM4(0, kt[dt][0], kt[dt][1], kt[dt][2], kt[dt][3]);
              const bf16x8 kf0 = ch_cat(kt[dt][0], kt[dt][1]), kf1 = ch_cat(kt[dt][2], kt[dt][3]);
              f32x4 acc = cacc[dt] * decay; acc = MFMA16(kf0, wf0, acc); acc = MFMA16(kf1, wf1, acc); cacc[dt] = acc;
              if ((dt >> 1) == wave) {
                  f32x4 na = MFMA16(kf0, ef0, z4); na = MFMA16(kf1, ef1, na);
                  if (lc == 0) { const f32x4 nn = *(const LAS f32x4*)(NVc + dt * 16 + 4 * lq) * decay + na; *(LAS f32x4*)(NVn + dt * 16 + 4 * lq) = nn;
                      v2u nb; nb.x = pg8::cvt_pk_bf16(nn[0], nn[1]); nb.y = pg8::cvt_pk_bf16(nn[2], nn[3]);
                      *(LAS v2u*)(L + CH5_NB + ((c + 1) & 1) * 512 + ((dt >> 1) * 32 + 8 * lq + 4 * (dt & 1)) * 2) = nb; } } }
#undef CH_KTR
        }
        asm volatile("" ::: "memory");
        CH_LD_S(c + 1);
        { bf16* hb_ = HRAW + r0 * D + h * 512 + slice * 128 + dvc; const unsigned hoff = (unsigned)(lc * D + 4 * lq);
#pragma unroll
          for (int ti = 0; ti < 4; ++ti) { const int t = ti * 16 + lc; const f32x4 o = nacc[ti] * sc[128 + t] + nac2[ti] * sc[64 + t];
              v2u w; w.x = pg8::cvt_pk_bf16(o[0], o[1]); w.y = pg8::cvt_pk_bf16(o[2], o[3]); *(GAS v2u*)(hb_ + ti * 16 * D + hoff) = w; }
          if (slice == 0 && lq == 0) { const int tq_ = wv & 3, t = tq_ * 16 + lc; float* dp = DENINV + ((r0 + t) * 4 + h) * 4;
              if (wv < 4) { const float rs_ = tq_ == 0 ? rsum[0] : (tq_ == 1 ? rsum[1] : (tq_ == 2 ? rsum[2] : rsum[3]));
                  *(GAS v2u*)dp = (v2u){__float_as_uint(sc[64 + t] * rs_ + sc[128 + t] * qacc[0]), __float_as_uint(sc[192 + t])}; }
              else dp[2] = sc[128 + t] * qacc[0]; } }
        asm volatile("s_waitcnt vmcnt(14)" ::: "memory");
    }
#undef CH_DMA_QK
#undef CH_DMA_V
#undef CH_LD_S
#undef CH_LD_SC
    asm volatile("s_waitcnt vmcnt(0)\n\ts_nop 0\n\ts_nop 0\n\ts_nop 0\n\ts_nop 0\n\ts_nop 0\n\ts_nop 0\n\ts_nop 0\n\ts_nop 0\n\ts_nop 0\n\ts_nop 0\n\ts_nop 0\n\ts_nop 0\n\ts_nop 0\n\ts_nop 0\n\ts_nop 0" : "+v"(sreg[0]), "+v"(sreg[1]), "+v"(sreg[2]), "+v"(sreg[3]), "+v"(sreg[4]), "+v"(sreg[5]), "+v"(sreg[6]), "+v"(sreg[7]) :: "memory");
    CH_BAR();
    int t2 = threadIdx.x; asm volatile("" : "+v"(t2));
    float* OC = F.out + O_CP + (size_t)bh * 256 * 512 + slice * 128 + dvc; float* ON = F.out + O_NP + (size_t)bh * 256;
    const unsigned ooff = (unsigned)((4 * ((t2 >> 4) & 3)) * 512 + (t2 & 15));
#pragma unroll
    for (int dt = 0; dt < 16; ++dt)
#pragma unroll
        for (int j = 0; j < 4; ++j) OC[(dt * 16 + j) * 512 + ooff] = cacc[dt][j];
    if (slice == 0 && t2 < 256) ON[t2] = NV[t2];
    if (slice == 0 && t2 == 0) F.out[O_MP + bh] = SCT[31 * 384 + 321];
    asm volatile("s_waitcnt vmcnt(0)" ::: "memory");
    __syncthreads();
}

constexpr int MS_Q = 0, MS_K = 1024, MS_KW = 2048, MS_V = 3072, MS_N = 5120, MS_SC = 5376, MS_SP = 5408, MS_QN = 5424, MS_RED = 5632, MS_END = MS_RED + 4 * 4 * 512;
static_assert(MS_END * 4 <= LDS_PHASE_BYTES, "sample mLSTM LDS");
__device__ __forceinline__ void mlstm_sample_unit(Frame& F, const Args& a, int b, int h) {
    const int tid = F.tid, lane = F.lane, wave = F.wave, bh = b * 4 + h;
    LAS float* L = (LAS float*)F.lds;
    const bf16* QC = WSP(bf16, WS_QC); const bf16* KC = WSP(bf16, WS_KC); const bf16* ZV = WSP(bf16, WS_Z) + (size_t)1 * M * D; const float* GT = WSP(float, WS_GATES); bf16* HRAW = WSP(bf16, WS_HRAW);
    const size_t r0 = (size_t)NP + 4 * b;
    { const int idx = tid * 2, row = idx >> 8, col = idx & 255;
      const unsigned qw = *(const GAS unsigned*)(QC + (r0 + row) * 1024 + h * 256 + col), kw = *(const GAS unsigned*)(KC + (r0 + row) * 1024 + h * 256 + col);
      L[MS_Q + idx] = bflo(qw); L[MS_Q + idx + 1] = bfhi(qw); L[MS_K + idx] = bflo(kw); L[MS_K + idx + 1] = bfhi(kw); }
    { const int idx = tid * 4, row = idx >> 9, col = idx & 511; const v2u vw = *(const GAS v2u*)(ZV + (r0 + row) * D + h * 512 + col);
      L[MS_V + idx] = bflo(vw.x); L[MS_V + idx + 1] = bfhi(vw.x); L[MS_V + idx + 2] = bflo(vw.y); L[MS_V + idx + 3] = bfhi(vw.y); }
    if (tid < 256) L[MS_N + tid] = a.in[I_SN][(size_t)bh * 256 + tid];
    if (tid < 16) L[MS_SP + tid] = 0.f;
    if (tid == 0) {
        const float m0 = a.in[I_SM][bh]; float bc = 0.f, pm = -INFINITY, as[4], Mt = m0;
#pragma unroll
        for (int t = 0; t < 4; ++t) { const float ig = GT[(r0 + t) * 8 + h], lf = GT[(r0 + t) * 8 + 4 + h]; bc += lf; as[t] = ig - bc; pm = fmaxf(pm, as[t]); Mt = fmaxf(m0, pm);
            L[MS_SC + t] = as[t]; L[MS_SC + 4 + t] = Mt; L[MS_SC + 8 + t] = __expf(m0 - Mt); L[MS_SC + 12 + t] = __expf(-(bc + Mt)); }
#pragma unroll
        for (int t = 0; t < 4; ++t) L[MS_SC + 16 + t] = __expf(as[t] - Mt);
        L[MS_SC + 20] = __expf(m0 - Mt); L[MS_SC + 21] = bc + Mt;
    }
    __syncthreads();
    for (int idx = wave; idx < 14; idx += NWAVES) {
        int t, s; const LAS float* y;
        if (idx < 10) { t = idx >= 6 ? 3 : (idx >= 3 ? 2 : (idx >= 1 ? 1 : 0)); s = idx - (t * (t + 1)) / 2; y = L + MS_K + s * 256; } else { t = idx - 10; s = 0; y = L + MS_N; }
        const LAS float* x = L + MS_Q + t * 256; float d = 0.f;
#pragma unroll
        for (int i = 0; i < 4; ++i) d += x[lane + 64 * i] * y[lane + 64 * i];
        d = wave_sum(d);
        if (lane == 0) { if (idx < 10) L[MS_SP + t * 4 + s] = d * __expf(L[MS_SC + s] - L[MS_SC + 4 + t]); else L[MS_QN + t] = d; }
    }
    { const int idx = tid * 2, s = idx >> 8; const float we = L[MS_SC + 16 + s]; L[MS_KW + idx] = L[MS_K + idx] * we; L[MS_KW + idx + 1] = L[MS_K + idx + 1] * we; }
    __syncthreads();
    const int rsub = tid >> 7, c4 = tid & 127; const float decay = L[MS_SC + 20];
    f32x4 vs[4], qc[4];
#pragma unroll
    for (int s = 0; s < 4; ++s) { vs[s] = *(const LAS f32x4*)(L + MS_V + s * 512 + 4 * c4); qc[s] = (f32x4){0.f, 0.f, 0.f, 0.f}; }
    const float* Cin = a.in[I_SC] + (size_t)bh * 256 * 512 + 4 * c4; float* Cout = F.out + O_CS + (size_t)bh * 256 * 512 + 4 * c4;
#pragma unroll 16
    for (int i = 0; i < 64; ++i) { const int d = 4 * i + rsub;
        const f32x4 c0 = __builtin_nontemporal_load((const f32x4*)(Cin + (size_t)d * 512));
        f32x4 cn = c0 * decay;
#pragma unroll
        for (int s = 0; s < 4; ++s) { cn += vs[s] * L[MS_KW + s * 256 + d]; qc[s] += c0 * L[MS_Q + s * 256 + d]; }
        __builtin_nontemporal_store(cn, (f32x4*)(Cout + (size_t)d * 512)); }
#pragma unroll
    for (int t = 0; t < 4; ++t) *(LAS f32x4*)(L + MS_RED + (rsub * 4 + t) * 512 + 4 * c4) = qc[t];
    __syncthreads();
    { const int t = rsub; f32x4 s = (f32x4){0.f, 0.f, 0.f, 0.f};
#pragma unroll
      for (int rs = 0; rs < 4; ++rs) s += *(const LAS f32x4*)(L + MS_RED + (rs * 4 + t) * 512 + 4 * c4);
      const float wp = L[MS_SC + 8 + t]; f32x4 num = s * wp; float den = wp * L[MS_QN + t];
#pragma unroll
      for (int s2 = 0; s2 < 4; ++s2) { const float sp = L[MS_SP + t * 4 + s2]; num += vs[s2] * sp; den += sp; }
      const float inv = 1.0f / fmaxf(fabsf(den), L[MS_SC + 12 + t]);
      const f32x4 o = num * inv; v2u w; w.x = pk2(o[0], o[1]); w.y = pk2(o[2], o[3]); *(GAS v2u*)(HRAW + (r0 + t) * D + h * 512 + 4 * c4) = w; }
    if (tid < 4) *(GAS f32x4*)(WSP(float, WS_DENINV) + ((r0 + tid) * 4 + h) * 4) = (f32x4){1.0f, 0.0f, 0.0f, 0.0f};
    if (tid < 256) { float nn = decay * L[MS_N + tid];
#pragma unroll
        for (int s = 0; s < 4; ++s) nn += L[MS_KW + s * 256 + tid];
        F.out[O_NS + (size_t)bh * 256 + tid] = nn; }
    if (tid == 0) F.out[O_MS + bh] = L[MS_SC + 21];
    __syncthreads();
}

__device__ __forceinline__ void headnorm_all(Frame& F, const Args& a) {
    const int gw = F.vcu * NWAVES + F.wave, NGW = F.G * NWAVES, lane = F.lane;
    const bf16* HRAW = WSP(bf16, WS_HRAW); const bf16* Z2 = WSP(bf16, WS_Z) + (size_t)2 * M * D; bf16* HA = WSP(bf16, WS_AB);
    f32x4 gh[8];
#pragma unroll
    for (int j = 0; j < 8; ++j) gh[j] = ((const GAS f32x4*)a.in[I_GHEAD])[lane + 64 * j];
    for (int r = gw; r < M; r += NGW) {
        const GAS v2u* hp = (const GAS v2u*)(HRAW + (size_t)r * D) + lane; f32x4 v[8]; float ss[4];
        f32x4 di;
#pragma unroll
        for (int hh = 0; hh < 4; ++hh) { const f32x4 x = *(const GAS f32x4*)(WSP(float, WS_DENINV) + ((size_t)r * 4 + hh) * 4); di[hh] = 1.0f / fmaxf(fabsf(x[0] + x[2]), x[1]); }
#pragma unroll
        for (int j = 0; j < 8; ++j) { const v2u hw = hp[64 * j]; v[j] = (f32x4){bflo(hw.x), bfhi(hw.x), bflo(hw.y), bfhi(hw.y)} * di[j >> 1]; }
#pragma unroll
        for (int hh = 0; hh < 4; ++hh) { ss[hh] = wave_sum(dot4(v[2 * hh], v[2 * hh]) + dot4(v[2 * hh + 1], v[2 * hh + 1])); ss[hh] = 1.0f / sqrtf(ss[hh] * (1.0f / 512.0f) + EPS); }
#pragma unroll
        for (int j = 0; j < 8; ++j) { const f32x4 g = gh[j]; const v2u ow = ((const GAS v2u*)(Z2 + (size_t)r * D))[lane + 64 * j];
            const f32x4 o = (f32x4){bflo(ow.x), bfhi(ow.x), bflo(ow.y), bfhi(ow.y)}; const f32x4 y = (v[j] * ss[j >> 1]) * g * o;
            v2u w; w.x = pk2(y[0], y[1]); w.y = pk2(y[2], y[3]); ((GAS v2u*)(HA + (size_t)r * (2 * D)))[lane + 64 * j] = w; }
    }
}

__device__ __forceinline__ void mixfix_all(Frame& F, int nslab) {
    const int gw = F.vcu * NWAVES + F.wave, NGW = F.G * NWAVES, lane = F.lane;
    bf16* MIX = WSP(bf16, WS_MIX);
    for (int r = gw; r < NS; r += NGW) {
        const GAS f32x4* sp = (const GAS f32x4*)(WSP(float, WS_SLAB) + (size_t)r * D) + lane; f32x4 t[8];
#pragma unroll
        for (int j = 0; j < 8; ++j) t[j] = sp[64 * j];
        _Pragma("unroll 1") for (int s = 1; s < nslab; ++s) { sp += (size_t)NS * D / 4;
#pragma unroll
            for (int j = 0; j < 8; ++j) t[j] += sp[64 * j]; }
#pragma unroll
        for (int j = 0; j < 8; ++j) { v2u w; w.x = pk2(t[j][0], t[j][1]); w.y = pk2(t[j][2], t[j][3]); ((GAS v2u*)(MIX + (size_t)(NP + r) * D))[lane + 64 * j] = w; }
    }
}

constexpr int AUX_CONV = (NITEMS_LATE + 31) / 32, AUX_TOTAL = 512 + 256 + 64 + AUX_CONV;
constexpr int IT_L0 = 4 * IT_SQ + IT_PU;
constexpr int AUX_TOTAL_256 = 512 + 256 + 64 + (IT_L0 - 2 * IT_SQ) / 32;
static_assert((IT_L0 - 2 * IT_SQ) % 32 == 0, "queue items");
__device__ __forceinline__ void aux_run(Frame& F, const Args& a, int item) {
    if (item < 512) mlstm_sample_unit(F, a, item >> 2, item & 3);
    else if (item < 768) { const int u = item - 512; gmlp_prompt_unit(F, a, u >> 6, (u >> 2) & 15, u & 3); }
    else if (item < 832) { const int it0 = (item - 768) * 8 + F.wave; gmlp_sample_items(F, a, it0, it0 + 1, 1); }
    else { LAS float* scr = (LAS float*)(F.lds + F.wave * 16384);
        const int base = (F.G == 256 ? 2 * IT_SQ : 0) + (item - 832) * 32 + F.wave * 4, lim = F.G == 256 ? IT_L0 : NITEMS_LATE;
        for (int i = 0; i < 4; ++i) if (base + i < lim) transpose_late(a, F, scr, base + i); }
}

__device__ __forceinline__ void relaunder(Frame& F) { int t = threadIdx.x; asm volatile("" : "+v"(t)); F.tid = t; F.lane = t & 63; }
__global__ void __launch_bounds__(NWAVES * 64, 2) fwd_kernel(Args args) {
    extern __shared__ __attribute__((aligned(16))) unsigned char lds[];
    Frame F;
    F.lds = (LAS unsigned char*)lds;
    F.MISC = (volatile LAS unsigned*)(F.lds + MISC_OFF);
    F.tid = threadIdx.x; F.lane = F.tid & 63; F.wave = __builtin_amdgcn_readfirstlane(F.tid >> 6);
    F.G = gridDim.x; { const int bx = blockIdx.x; F.vcu = (F.G % 8 == 0) ? (bx % 8) * (F.G / 8) + bx / 8 : bx; }
    F.ws = args.ws; F.out = args.out;
    if (F.tid < 64) ((LAS unsigned*)(F.lds + MISC_OFF))[F.tid] = 0u;
    __syncthreads();
#if MK_SINGLE
    XcdBarrier bar = xcd_barrier_post((unsigned*)(F.ws + WS_CTL) + CW_BAR, F.MISC + 8);
#define GRID_BAR() xcd_barrier(bar)
#else
#define GRID_BAR() do { } while (0)
#endif
    const int lo = args.ph_lo, hi = args.ph_hi;
#ifndef PH_MASK
#define PH_MASK 0x1FFFF
#endif
#define IN(k) ((((PH_MASK) >> (k)) & 1) && lo <= (k) && (k) < hi)
#ifndef PH_REP
#define PH_REP 0
#endif
#define NREP(k) (1 + (((PH_REP) >> (k)) & 1))
#define PHASE(k) if (IN(k)) for (int rep_ = (relaunder(F), 0); rep_ < NREP(k); ++rep_)
    const int BX = (int)blockIdx.x;
#if MK_SINGLE
#define SEAM(k) do { if (IN(k) && IN((k) + 1)) { if (lo < 0) cooperative_groups::this_grid().sync(); else GRID_BAR(); } } while (0)
#else
#define SEAM(k) do { } while (0)
#endif
    const Args& a = args;
    bf16* XN = WSP(bf16, WS_XN); bf16* HFF = WSP(bf16, WS_HFF); bf16* T32 = WSP(bf16, WS_T32);     bf16* H = WSP(bf16, WS_H);

    PHASE(0) { p0_prologue(F, a); } SEAM(0);
    PHASE(1) { pg8::Gemm g{XN, WSP(bf16, WS_W1), M, 2 * FF, D, D / 64}; pg8::StaticOrder S; S.init(M, 2 * FF, F.G, BX); pg8::EpiSwiGLU E{HFF, FF};
        pg8::gemm_phase<pg8::EpiSwiGLU, pg8::StaticOrder, true, true>(F.lds, g, S, E);
        relaunder(F); transpose_tail(F, a, BX, 216, 2 * IT_FG, IT_FD); } SEAM(1);

    PHASE(2) { { pg8::Gemm g{HFF, WSP(bf16, WS_W1D), NP, D, FF, FF / 64}; pg8::StaticOrder S; S.init(NP, D, F.G, BX); pg8::EpiT16 E{T32};
            pg8::gemm_phase<pg8::EpiT16, pg8::StaticOrder, true, true>(F.lds, g, S, E); }
        { pg8::Gemm g{HFF, WSP(bf16, WS_W1D), M, D, FF, 22}; pg8::SplitOrder S{BX, 4, 22, 0}; pg8::EpiSlab E{WSP(float, WS_SLAB), 22};
            pg8::gemm_phase<pg8::EpiSlab, pg8::SplitOrder, true, true>(F.lds, g, S, E); }
        relaunder(F); transpose_tail(F, a, BX, 64, 2 * IT_FG + IT_FD, IT_INA + IT_INB); } SEAM(2);

    PHASE(3) { rowwise<1, false, 1>(F, a, nullptr, T32, a.in[I_G1POST], 0.5f, a.in[I_GMIXPRE], H, XN, nullptr, 4); } SEAM(3);
    PHASE(4) { pg8::Gemm g{XN, WSP(bf16, WS_WIN), M, NZG, D, D / 64}; pg8::ZOrder S; S.s.init(M, NZG, F.G, BX); pg8::EpiZ E{WSP(bf16, WS_Z), WSP(float, WS_STAT), F.out + O_CONVP, F.out + O_CONVS, WSP(float, WS_GATES), a.in[I_BI], a.in[I_BF]};
        pg8::gemm_phase<pg8::EpiZ, pg8::ZOrder, true, true>(F.lds, g, S, E);
        relaunder(F); transpose_tail<true>(F, a, BX, 146, 0, 2 * IT_SQ); transpose_tail<true>(F, a, BX, 146, IT_L0, IT_FG); } SEAM(4);

    PHASE(5) { for (int u = F.vcu; u < 16; u += F.G) mlstm_scalar_table_wg(F, u);
        for (int u = F.vcu; u < 512; u += F.G) sraw_item(F, a, u >> 5, u & 31);
        conv_silu_all(F, a); } SEAM(5);
    PHASE(6) { for (int u = F.vcu; u < 64; u += F.G) mlstm_chain_unit(F, a, u >> 2, u & 3);
        relaunder(F);
        unsigned* qctr = (unsigned*)(F.ws + WS_CTL) + CW_QUEUE;
        for (;;) { relaunder(F);     if (F.tid == 0) F.MISC[16] = atomicAdd(qctr, 1u); __syncthreads(); const int item = (int)F.MISC[16]; __syncthreads(); if (item >= (F.G == 256 ? AUX_TOTAL_256 : AUX_TOTAL)) break; aux_run(F, a, item); } } SEAM(6);
    PHASE(7) { headnorm_all(F, a); } SEAM(7);
    PHASE(8) { { pg8::Gemm g{WSP(bf16, WS_AB), WSP(bf16, WS_WAB), NP, D, 2 * D, 2 * D / 64}; pg8::StaticOrder S; S.init(NP, D, F.G, BX);
            pg8::EpiMerge E{WSP(bf16, WS_Z) + (size_t)5 * M * D, WSP(bf16, WS_Z) + (size_t)6 * M * D, WSP(bf16, WS_MIX)};
            pg8::gemm_phase<pg8::EpiMerge, pg8::StaticOrder, true, true>(F.lds, g, S, E); }
        { pg8::Gemm g{WSP(bf16, WS_AB), WSP(bf16, WS_WAB), M, D, 2 * D, 8}; pg8::SplitOrder S{BX, 8, 8, 0};
            pg8::EpiMergeSlab E{WSP(bf16, WS_Z) + (size_t)5 * M * D, WSP(bf16, WS_Z) + (size_t)6 * M * D, WSP(float, WS_SLAB), 8};
            pg8::gemm_phase<pg8::EpiMergeSlab, pg8::SplitOrder, true, true>(F.lds, g, S, E); }
        relaunder(F); transpose_tail<true>(F, a, BX, 128, IT_L0 + IT_FG, IT_FG); } SEAM(8);
    PHASE(9) { mixfix_all(F, 8);
        if (F.G == 256) { unsigned* mixcnt = (unsigned*)(F.ws + WS_CTL) + CW_MIXCNT;
            asm volatile("s_waitcnt vmcnt(0)" ::: "memory"); __syncthreads();
            if (F.tid == 0) { __builtin_amdgcn_fence(__ATOMIC_RELEASE, "agent"); asm volatile("s_waitcnt vmcnt(0)" ::: "memory"); __hip_atomic_fetch_add(mixcnt, 1u, __ATOMIC_RELAXED, __HIP_MEMORY_SCOPE_AGENT); } }
        else { __syncthreads();
            pg8::Gemm g{WSP(bf16, WS_PB), WSP(bf16, WS_WPU), M, D, DPLE, DPLE / 64}; pg8::StaticOrder S; S.init(M, D, F.G, BX); pg8::EpiT16 E{WSP(bf16, WS_PUP)};
            pg8::gemm_phase<pg8::EpiT16, pg8::StaticOrder, true, true>(F.lds, g, S, E); } }
    if (F.G != 256) { SEAM(9); }
    PHASE(10) { { pg8::Gemm g{WSP(bf16, WS_MIX), WSP(bf16, WS_WO), NP, D, D, D / 64}; pg8::StaticOrder S; S.init(NP, D, F.G, BX); pg8::EpiT16 E{T32};
            pg8::gemm_phase<pg8::EpiT16, pg8::StaticOrder, true, true>(F.lds, g, S, E); }
        if (F.G == 256 && IN(9) && BX < 128) { unsigned* mixcnt = (unsigned*)(F.ws + WS_CTL) + CW_MIXCNT;
            if (F.tid == 0) { unsigned sp_ = 0; while (__hip_atomic_load(mixcnt, __ATOMIC_RELAXED, __HIP_MEMORY_SCOPE_AGENT) < (unsigned)F.G && ++sp_ < (1u << 22)) __builtin_amdgcn_s_sleep(1);
                __builtin_amdgcn_fence(__ATOMIC_ACQUIRE, "agent"); asm volatile("s_waitcnt vmcnt(0)" ::: "memory"); }
            __syncthreads(); }
        { pg8::Gemm g{WSP(bf16, WS_MIX), WSP(bf16, WS_WO), M, D, D, 4}; pg8::SplitOrder S{BX, 8, 4, 0}; pg8::EpiSlab E{WSP(float, WS_SLAB), 4};
            pg8::gemm_phase<pg8::EpiSlab, pg8::SplitOrder, true, true>(F.lds, g, S, E); } } SEAM(10);
    PHASE(11) { rowwise<1, false, 1>(F, a, H, T32, a.in[I_GMIXPOST], 1.0f, a.in[I_G2PRE], H, XN, nullptr, 8); } SEAM(11);
    PHASE(12) { pg8::Gemm g{XN, WSP(bf16, WS_W2), M, 2 * FF, D, D / 64}; pg8::StaticOrder S; S.init(M, 2 * FF, F.G, BX); pg8::EpiSwiGLU E{HFF, FF};
        pg8::gemm_phase<pg8::EpiSwiGLU, pg8::StaticOrder, true, true>(F.lds, g, S, E);
        relaunder(F); transpose_tail<true>(F, a, BX, 216, IT_L0 + 2 * IT_FG, IT_FD); } SEAM(12);
    PHASE(13) { { pg8::Gemm g{HFF, WSP(bf16, WS_W2D), NP, D, FF, FF / 64}; pg8::StaticOrder S; S.init(NP, D, F.G, BX); pg8::EpiT16 E{T32};
            pg8::gemm_phase<pg8::EpiT16, pg8::StaticOrder, true, true>(F.lds, g, S, E); }
        { pg8::Gemm g{HFF, WSP(bf16, WS_W2D), M, D, FF, 22}; pg8::SplitOrder S{BX, 4, 22, 0}; pg8::EpiSlab E{WSP(float, WS_SLAB), 22};
            pg8::gemm_phase<pg8::EpiSlab, pg8::SplitOrder, true, true>(F.lds, g, S, E); }
        if (F.G == 256 && BX >= 64) {
            pg8::Gemm g{WSP(bf16, WS_PB), WSP(bf16, WS_WPU), M, D, DPLE, DPLE / 64}; pg8::StaticOrder S; S.init(M, D, 192, BX - 64); pg8::EpiT16 E{WSP(bf16, WS_PUP)};
            pg8::gemm_phase<pg8::EpiT16, pg8::StaticOrder, true, true>(F.lds, g, S, E); } } SEAM(13);
    PHASE(14) { rowwise<1, false, 1>(F, a, H, T32, a.in[I_G2POST], 0.5f, a.in[I_GPLEPRE], H, XN, nullptr, 4);
 } SEAM(14);
    PHASE(15) { { pg8::Gemm g{XN, WSP(bf16, WS_WPG), NP, D, D, D / 64}; pg8::StaticOrder S; S.init(NP, D, F.G, BX); pg8::EpiPle16 E{WSP(bf16, WS_PUP), T32};
            pg8::gemm_phase<pg8::EpiPle16, pg8::StaticOrder, true, true>(F.lds, g, S, E); }
        { pg8::Gemm g{XN, WSP(bf16, WS_WPG), M, D, D, 4}; pg8::SplitOrder S{BX, 8, 4, 0}; pg8::EpiSlab E{WSP(float, WS_SLAB), 4};
            pg8::gemm_phase<pg8::EpiSlab, pg8::SplitOrder, true, true>(F.lds, g, S, E); } } SEAM(15);
    PHASE(16) { rowwise<2, false, 2>(F, a, H, T32, a.in[I_GPLEPOST], 1.0f, nullptr, nullptr, nullptr, F.out + O_Y, 8, WSP(bf16, WS_PUP)); }
#undef IN
#undef SEAM
}

extern "C" void kernel_launch(void* const* d_in, const int* in_sizes, int n_in, void* d_out, int out_size, void* d_ws, size_t ws_size, hipStream_t stream) {
    static int grid = 0;
    if (grid == 0) {
        if (n_in != N_IN || (size_t)out_size != O_END || ws_size < WS_END) { fprintf(stderr, "kernel_launch: unexpected sizes: n_in %d out %d ws %zu (need %d, %zu, >= %zu)\n", n_in, out_size, ws_size, (int)N_IN, (size_t)O_END, (size_t)WS_END); grid = -1; return; }
        int dev = 0, cus = 0, per_cu = 0;
        if (hipGetDevice(&dev) != hipSuccess || hipDeviceGetAttribute(&cus, hipDeviceAttributeMultiprocessorCount, dev) != hipSuccess) { grid = -1; return; }
        if (hipFuncSetAttribute((const void*)fwd_kernel, hipFuncAttributeMaxDynamicSharedMemorySize, LDS_BYTES) != hipSuccess) { fprintf(stderr, "kernel_launch: hipFuncSetAttribute failed\n"); grid = -1; return; }
        if (hipOccupancyMaxActiveBlocksPerMultiprocessor(&per_cu, (const void*)fwd_kernel, NWAVES * 64, LDS_BYTES) != hipSuccess || per_cu < 1) { fprintf(stderr, "kernel_launch: occupancy query says %d\n", per_cu); (void)hipGetLastError(); }
        grid = cus;
    }
    if (grid < 0) return;
    Args a{};
    for (int i = 0; i < N_IN; ++i) a.in[i] = (const float*)d_in[i];
    a.out = (float*)d_out; a.ws = (unsigned char*)d_ws;
    (void)hipMemsetAsync((char*)d_ws + WS_CTL, 0, CTL_ZERO_BYTES, stream);
#if MK_SINGLE
    a.ph_lo = 0; a.ph_hi = N_PHASES;
    void* kargs[] = {&a};
    hipError_t e = hipLaunchCooperativeKernel((const void*)fwd_kernel, dim3(grid), dim3(NWAVES * 64), kargs, LDS_BYTES, stream);
    if (e != hipSuccess) fprintf(stderr, "kernel_launch: cooperative launch failed: %s (grid %d)\n", hipGetErrorString(e), grid);
#else
    for (int p = 0; p < N_PHASES; ++p) { a.ph_lo = p; a.ph_hi = p + 1; hipLaunchKernelGGL(fwd_kernel, dim3(grid), dim3(NWAVES * 64), LDS_BYTES, stream, a); }
#endif
}
```

```cpp
#include <hip/hip_runtime.h>
#include <hip/hip_cooperative_groups.h>
#include <cstdio>
#include <cstdint>

constexpr int D = 2048, NP = 8192, NS = 512, M = NP + NS, FF = 5632, DPLE = 256;
constexpr int NZ = 14336;
constexpr int NZG = NZ + 256;
constexpr int SEQ = 2048, DECB = 128;
constexpr float EPS = 1e-6f;

namespace pg8 {
#define PG8_LAS __attribute__((address_space(3)))
typedef unsigned short bf16_t;
typedef short bf16x8 __attribute__((ext_vector_type(8)));
typedef float f32x4 __attribute__((ext_vector_type(4)));
typedef unsigned u32x4 __attribute__((ext_vector_type(4)));
constexpr int BM = 256, BK = 64, HALF = 128, HTB = HALF * BK * 2  , STAGE_BYTES = 8 * HTB, NXCD = 8, WGM = 4;

__host__ __device__ __forceinline__ int lds_byte(int r, int c) { const int st = (r >> 4) * 2 + (c >> 5), rr = r & 15, cc = c & 31, ob = rr * 64 + cc * 2; return st * 1024 + (ob ^ (((ob >> 9) & 1) << 5)); }
__host__ __device__ __forceinline__ void stage_rc(int b, int& R, int& C) { const int st = b / 1024, sb = b % 1024, swz = sb ^ (((sb >> 9) & 1) << 5); R = (st >> 1) * 16 + swz / 64; C = (st & 1) * 32 + (swz % 64) / 2; }
__host__ __device__ __forceinline__ int perm32(int rho) { const int n = rho >> 4, i = rho & 15; return 8 * (i >> 2) + 4 * n + (i & 3); }

struct Unit { int pm, pn, kt0; };
struct Gemm { const bf16_t* A; const bf16_t* Bt; int M, N, K, nt; };

struct StaticOrder {
    int nM, nN, nwg, G, c;
    __host__ __device__ void init(int M, int N, int G_, int c_) { nM = M / BM; nN = N / BM; nwg = nM * nN; G = G_; c = c_; }
    __host__ __device__ bool next(int i, Unit& u) const {
        const long L = (long)i * G + c; if (L >= nwg) return false;
        int wgid = (int)L; { const int q = nwg / NXCD, r = nwg % NXCD, xcd = wgid % NXCD, off = wgid / NXCD; wgid = (xcd < r ? xcd * (q + 1) : r * (q + 1) + (xcd - r) * q) + off; }
        const int nig = WGM * nN, gid = wgid / nig, fm = gid * WGM, gsz = (nM - fm) < WGM ? (nM - fm) : WGM;
        u.pm = fm + ((wgid % nig) % gsz); u.pn = (wgid % nig) / gsz; u.kt0 = 0; return true;
    }
    __device__ __forceinline__ void a_ready(const Unit&) const {}
    __device__ __forceinline__ void done(const Unit&) const {}
};

__device__ __forceinline__ unsigned cvt_pk_bf16(float lo, float hi) { unsigned r; asm volatile("v_cvt_pk_bf16_f32 %0, %1, %2" : "=v"(r) : "v"(lo), "v"(hi)); return r; }
typedef float f32x2 __attribute__((ext_vector_type(2)));
__device__ __forceinline__ f32x2 gelu_pk(f32x2 v) {
    const f32x2 av = __builtin_elementwise_abs(v), d = av * 0.2316418882f + 1.0f;
    f32x2 t; t.x = __builtin_amdgcn_rcpf(d.x); t.y = __builtin_amdgcn_rcpf(d.y);
    f32x2 q = t * 0.5307027145f + (-0.7265760135f); q = q * t + 0.7107068705f; q = q * t + (-0.142248368f); q = q * t + 0.127414796f; q = q * t;
    const f32x2 s = (v * v) * (-0.72134752044f);
    f32x2 e; e.x = __builtin_amdgcn_exp2f(s.x); e.y = __builtin_amdgcn_exp2f(s.y);
    const f32x2 m = v * (q * e), r = v - m;
    f32x2 o; o.x = v.x < 0.f ? m.x : r.x; o.y = v.y < 0.f ? m.y : r.y; return o;
}


typedef unsigned u32x2 __attribute__((ext_vector_type(2)));
__device__ __forceinline__ float sigm(float x) { return __builtin_amdgcn_rcpf(1.0f + __expf(-x)); }
__device__ __forceinline__ f32x4 sigm4(f32x4 v) { return (f32x4){sigm(v[0]), sigm(v[1]), sigm(v[2]), sigm(v[3])}; }
__device__ __forceinline__ f32x4 gelu4(f32x4 v) { const f32x2 a = gelu_pk((f32x2){v[0], v[1]}), b = gelu_pk((f32x2){v[2], v[3]}); return (f32x4){a.x, a.y, b.x, b.y}; }
__device__ __forceinline__ float bfl(unsigned w) { return __uint_as_float(w << 16); }
__device__ __forceinline__ float bfh(unsigned w) { return __uint_as_float(w & 0xffff0000u); }

struct EpiF32 {
    static constexpr bool PERM = false, AFTER_DRAIN = false, MIDHOOK = false;
    float* C; int ldc;
    __device__ __forceinline__ void operator()(const f32x4 (&acc)[2][2][4][2], const Unit& u, int wr, int wc, int fr, int fq) const {
        const int row0 = u.pm * BM + wr * 64 + fr, col0 = u.pn * BM + wc * 32 + 4 * fq;
#pragma unroll
        for (int ai = 0; ai < 2; ++ai)
#pragma unroll
            for (int m = 0; m < 4; ++m) { float* rowp = C + (size_t)(row0 + ai * HALF + m * 16) * ldc + col0;
#pragma unroll
                for (int bj = 0; bj < 2; ++bj)
#pragma unroll
                    for (int n = 0; n < 2; ++n) *(f32x4*)(rowp + bj * HALF + n * 16) = acc[ai][bj][m][n]; }
    }
};
struct EpiSwiGLU {
    static constexpr bool PERM = true, AFTER_DRAIN = false, MIDHOOK = false;
    bf16_t* O; int ldc;
    __device__ __forceinline__ void operator()(const f32x4 (&acc)[2][2][4][2], const Unit& u, int wr, int wc, int fr, int fq) const {
        const int row0 = u.pm * BM + wr * 64 + fr, col0 = u.pn * HALF + wc * 32 + 8 * fq;
#pragma unroll
        for (int ai = 0; ai < 2; ++ai)
#pragma unroll
            for (int m = 0; m < 4; ++m) { bf16_t* rowp = O + (size_t)(row0 + ai * HALF + m * 16) * ldc + col0;
                const f32x4 g0 = acc[ai][0][m][0], g1 = acc[ai][0][m][1], u0 = acc[ai][1][m][0], u1 = acc[ai][1][m][1];
                const f32x4 h0 = g0 * sigm4(g0) * u0, h1 = g1 * sigm4(g1) * u1;
                u32x4 w; w.x = cvt_pk_bf16(h0[0], h0[1]); w.y = cvt_pk_bf16(h0[2], h0[3]); w.z = cvt_pk_bf16(h1[0], h1[1]); w.w = cvt_pk_bf16(h1[2], h1[3]);
                *(u32x4*)rowp = w; }
    }
};
struct EpiZ {
    static constexpr bool PERM = true, AFTER_DRAIN = false, MIDHOOK = false;
    bf16_t* Z; float* stat; float* conv_p; float* conv_s; float* gates; const float* b_i; const float* b_f;
    __device__ __forceinline__ void operator()(const f32x4 (&acc)[2][2][4][2], const Unit& u, int wr, int wc, int fr, int fq) const {
        const int sec = u.pn >> 3, pnl = u.pn & 7;
        if (sec == 7) {
            if (wc == 0 && fq == 0) { const f32x4 bi = *(const f32x4*)b_i, bf = *(const f32x4*)b_f;
#pragma unroll
                for (int ai = 0; ai < 2; ++ai)
#pragma unroll
                    for (int m = 0; m < 4; ++m) { const int r = u.pm * BM + wr * 64 + fr + ai * HALF + m * 16; const f32x4 x = acc[ai][0][m][1] + bf; f32x4 lf;
#pragma unroll
                        for (int e = 0; e < 4; ++e) lf[e] = fminf(x[e], 0.f) - __logf(1.0f + __expf(-fabsf(x[e])));
                        *(f32x4*)(gates + (size_t)r * 8) = acc[ai][0][m][0] + bi; *(f32x4*)(gates + (size_t)r * 8 + 4) = lf; } }
            return; }
        bf16_t* Zs = Z + (size_t)sec * ((size_t)M * D);
        const int row0 = u.pm * BM + wr * 64 + fr, col0 = pnl * BM + wc * 32 + 8 * fq;
#pragma unroll
        for (int ai = 0; ai < 2; ++ai)
#pragma unroll
            for (int m = 0; m < 4; ++m) { const int r = row0 + ai * HALF + m * 16; float s1 = 0.f, s2 = 0.f;
#pragma unroll
                for (int bj = 0; bj < 2; ++bj) { f32x4 v0 = acc[ai][bj][m][0], v1 = acc[ai][bj][m][1];
                    if (sec == 0) {
                        float* dst = nullptr;
                        if (r < NP) { const int t = r & (SEQ - 1); if (t >= SEQ - 3) dst = conv_p + (size_t)((r >> 11) * 3 + (t - (SEQ - 3))) * D; }
                        else { const int s = r - NP, t = s & 3; if (t >= 1) dst = conv_s + (size_t)((s >> 2) * 3 + (t - 1)) * D; }
                        if (dst) { *(f32x4*)(dst + col0 + bj * HALF) = v0; *(f32x4*)(dst + col0 + bj * HALF + 4) = v1; }
                    } else if (sec == 2 || sec >= 5) { v0 = sigm4(v0); v1 = sigm4(v1); }
                    else if (sec >= 3) { v0 = gelu4(v0); v1 = gelu4(v1);
                        if (sec == 4) { s1 += (v0[0] + v0[1]) + (v0[2] + v0[3]) + (v1[0] + v1[1]) + (v1[2] + v1[3]);
                            s2 += (v0[0] * v0[0] + v0[1] * v0[1]) + (v0[2] * v0[2] + v0[3] * v0[3]) + (v1[0] * v1[0] + v1[1] * v1[1]) + (v1[2] * v1[2] + v1[3] * v1[3]); } }
                    u32x4 w; w.x = cvt_pk_bf16(v0[0], v0[1]); w.y = cvt_pk_bf16(v0[2], v0[3]); w.z = cvt_pk_bf16(v1[0], v1[1]); w.w = cvt_pk_bf16(v1[2], v1[3]);
                    *(u32x4*)(Zs + (size_t)r * D + col0 + bj * HALF) = w; }
                if (sec == 4) { s1 += __shfl_xor(s1, 16); s1 += __shfl_xor(s1, 32); s2 += __shfl_xor(s2, 16); s2 += __shfl_xor(s2, 32);
                    if (fq == 0) { float* sp = stat + ((size_t)r * 32 + pnl * 4 + wc) * 2; sp[0] = s1; sp[1] = s2; } } }
    }
};
struct ZOrder {
    StaticOrder s;
    __device__ bool next(int i, Unit& u) const { if (!s.next(i, u)) return false; const int p = u.pn; u.pn = p < 56 ? (p % 7) * 8 + p / 7 : p; return true; }
    __device__ __forceinline__ void a_ready(const Unit&) const {}
    __device__ __forceinline__ void done(const Unit&) const {}
};
struct EpiDual {
    static constexpr bool PERM = false, AFTER_DRAIN = false, MIDHOOK = false;
    const bf16_t* GA; const bf16_t* GB; float* T; bf16_t* MIX;
    __device__ __forceinline__ void operator()(const f32x4 (&acc)[2][2][4][2], const Unit& u, int wr, int wc, int fr, int fq) const {
        const int pass = u.pm >= (M / BM) ? 1 : 0, pm = u.pm - pass * (M / BM), pn = u.pn - pass * (D / BM);
        const bf16_t* G = pass ? GB : GA;
        const int row0 = pm * BM + wr * 64 + fr, col0 = pn * BM + wc * 32 + 4 * fq;
#pragma unroll
        for (int ai = 0; ai < 2; ++ai)
#pragma unroll
            for (int m = 0; m < 4; ++m) { const size_t ro = (size_t)(row0 + ai * HALF + m * 16) * D + col0;
#pragma unroll
                for (int bj = 0; bj < 2; ++bj)
#pragma unroll
                    for (int n = 0; n < 2; ++n) { const size_t o = ro + bj * HALF + n * 16;
                        const u32x2 gw = *(const u32x2*)(G + o); const f32x4 g = (f32x4){bfl(gw.x), bfh(gw.x), bfl(gw.y), bfh(gw.y)};
                        const f32x4 v = g * acc[ai][bj][m][n];
                        if (!pass) *(f32x4*)(T + o) = v;
                        else { const f32x4 s = *(const f32x4*)(T + o) + v; u32x2 w; w.x = cvt_pk_bf16(s[0], s[1]); w.y = cvt_pk_bf16(s[2], s[3]); *(u32x2*)(MIX + o) = w; } }
                asm volatile("" ::: "memory"); }
    }
};
struct EpiPle {
    static constexpr bool PERM = false, AFTER_DRAIN = false, MIDHOOK = false;
    const float* PUP; float* T;
    __device__ __forceinline__ void operator()(const f32x4 (&acc)[2][2][4][2], const Unit& u, int wr, int wc, int fr, int fq) const {
        const int row0 = u.pm * BM + wr * 64 + fr, col0 = u.pn * BM + wc * 32 + 4 * fq;
#pragma unroll
        for (int ai = 0; ai < 2; ++ai)
#pragma unroll
            for (int m = 0; m < 4; ++m) { const size_t ro = (size_t)(row0 + ai * HALF + m * 16) * D + col0;
#pragma unroll
                for (int bj = 0; bj < 2; ++bj)
#pragma unroll
                    for (int n = 0; n < 2; ++n) { const size_t o = ro + bj * HALF + n * 16; *(f32x4*)(T + o) = sigm4(acc[ai][bj][m][n]) * *(const f32x4*)(PUP + o); }
                asm volatile("" ::: "memory"); }
    }
};
struct DualOrder {
    StaticOrder s;
    __device__ bool next(int i, Unit& u) const { Unit t; if (!s.next(i >> 1, t)) return false; const int pass = i & 1; u.pm = t.pm + pass * (M / BM); u.pn = t.pn + pass * (D / BM); u.kt0 = 0; return true; }
    __device__ __forceinline__ void a_ready(const Unit&) const {}
    __device__ __forceinline__ void done(const Unit&) const {}
};


struct SplitOrder {
    int c, S, ntsub, dual;
    __device__ bool next(int i, Unit& u) const { int dl = dual; asm volatile("" : "+s"(dl));
        if (c >= 16 * S || i >= 1 + dl) return false; const int tile = c & 15, slice = c >> 4;
        u.pm = NP / BM + (tile >> 3) + i * (M / BM); u.pn = (tile & 7) + i * (D / BM); u.kt0 = slice * ntsub; return true; }
    __device__ __forceinline__ void a_ready(const Unit&) const {}
    __device__ __forceinline__ void done(const Unit&) const {}
};
struct EpiSlab {
    static constexpr bool PERM = false, AFTER_DRAIN = false, MIDHOOK = false;
    float* slab; int ntsub;
    __device__ __forceinline__ void operator()(const f32x4 (&acc)[2][2][4][2], const Unit& u, int wr, int wc, int fr, int fq) const {
        float* C = slab + (size_t)(u.kt0 / ntsub) * ((size_t)NS * D);
        const int row0 = (u.pm - NP / BM) * BM + wr * 64 + fr, col0 = u.pn * BM + wc * 32 + 4 * fq;
#pragma unroll
        for (int ai = 0; ai < 2; ++ai)
#pragma unroll
            for (int m = 0; m < 4; ++m) { float* rowp = C + (size_t)(row0 + ai * HALF + m * 16) * D + col0;
#pragma unroll
                for (int bj = 0; bj < 2; ++bj)
#pragma unroll
                    for (int n = 0; n < 2; ++n) *(f32x4*)(rowp + bj * HALF + n * 16) = acc[ai][bj][m][n]; }
    }
};
struct EpiDualSlab {
    static constexpr bool PERM = false, AFTER_DRAIN = false, MIDHOOK = false;
    const bf16_t* GA; const bf16_t* GB; float* slab; int ntsub;
    __device__ __forceinline__ void operator()(const f32x4 (&acc)[2][2][4][2], const Unit& u, int wr, int wc, int fr, int fq) const {
        const int pass = u.pm >= (NP / BM + M / BM) ? 1 : 0, pm = u.pm - NP / BM - pass * (M / BM), pn = u.pn - pass * (D / BM);
        const bf16_t* G = (pass ? GB : GA) + (size_t)NP * D;
        float* C = slab + (size_t)(u.kt0 / ntsub) * ((size_t)NS * D);
        const int row0 = pm * BM + wr * 64 + fr, col0 = pn * BM + wc * 32 + 4 * fq;
#pragma unroll
        for (int ai = 0; ai < 2; ++ai)
#pragma unroll
            for (int m = 0; m < 4; ++m) { const size_t ro = (size_t)(row0 + ai * HALF + m * 16) * D + col0;
#pragma unroll
                for (int bj = 0; bj < 2; ++bj)
#pragma unroll
                    for (int n = 0; n < 2; ++n) { const size_t o = ro + bj * HALF + n * 16;
                        const u32x2 gw = *(const u32x2*)(G + o); const f32x4 g = (f32x4){bfl(gw.x), bfh(gw.x), bfl(gw.y), bfh(gw.y)};
                        const f32x4 v = g * acc[ai][bj][m][n];
                        if (!pass) *(f32x4*)(C + o) = v; else *(f32x4*)(C + o) = *(const f32x4*)(C + o) + v; }
                asm volatile("" ::: "memory"); }
    }
};


__device__ __forceinline__ void unpack8(u32x4 w, f32x4& lo, f32x4& hi) { lo = (f32x4){bfl(w.x), bfh(w.x), bfl(w.y), bfh(w.y)}; hi = (f32x4){bfl(w.z), bfh(w.z), bfl(w.w), bfh(w.w)}; }
struct EpiMerge {
    static constexpr bool PERM = true, AFTER_DRAIN = false, MIDHOOK = true;
    const bf16_t* GA; const bf16_t* GB; bf16_t* MIX;
    __device__ __forceinline__ void mid(f32x4 (&acc)[2][2][4][2], const Unit& u, int wr, int wc, int fr, int fq) const {
        int lo_ = fr * D + 8 * fq; asm volatile("" : "+v"(lo_));
        const unsigned base = (unsigned)((u.pm * BM + wr * 64) * D + u.pn * BM + wc * 32) + (unsigned)lo_;
#pragma unroll
        for (int ai = 0; ai < 2; ++ai)
#pragma unroll
            for (int m = 0; m < 4; ++m) { const unsigned ro = base + (unsigned)((ai * HALF + m * 16) * D);
#pragma unroll
                for (int bj = 0; bj < 2; ++bj) { const u32x4 aw = *(const u32x4*)(GA + ro + bj * HALF), bw = *(const u32x4*)(GB + ro + bj * HALF);
                    f32x4 a0, a1, b0, b1; unpack8(aw, a0, a1); unpack8(bw, b0, b1);
#pragma unroll
                    for (int e = 0; e < 4; ++e) { acc[ai][bj][m][0][e] *= a0[e] * __builtin_amdgcn_rcpf(fmaxf(b0[e], 1e-20f)); acc[ai][bj][m][1][e] *= a1[e] * __builtin_amdgcn_rcpf(fmaxf(b1[e], 1e-20f)); } }
                asm volatile("" ::: "memory"); }
    }
    __device__ __forceinline__ void operator()(const f32x4 (&acc)[2][2][4][2], const Unit& u, int wr, int wc, int fr, int fq) const {
        const int row0 = u.pm * BM + wr * 64 + fr, col0 = u.pn * BM + wc * 32 + 8 * fq;
#pragma unroll
        for (int ai = 0; ai < 2; ++ai)
#pragma unroll
            for (int m = 0; m < 4; ++m) { const size_t ro = (size_t)(row0 + ai * HALF + m * 16) * D + col0;
#pragma unroll
                for (int bj = 0; bj < 2; ++bj) { const u32x4 bw = *(const u32x4*)(GB + ro + bj * HALF); f32x4 b0, b1; unpack8(bw, b0, b1);
                    f32x4 v0 = acc[ai][bj][m][0], v1 = acc[ai][bj][m][1];
#pragma unroll
                    for (int e = 0; e < 4; ++e) { v0[e] *= fmaxf(b0[e], 1e-20f); v1[e] *= fmaxf(b1[e], 1e-20f); }
                    u32x4 w; w.x = cvt_pk_bf16(v0[0], v0[1]); w.y = cvt_pk_bf16(v0[2], v0[3]); w.z = cvt_pk_bf16(v1[0], v1[1]); w.w = cvt_pk_bf16(v1[2], v1[3]);
                    *(u32x4*)(MIX + ro + bj * HALF) = w; }
                asm volatile("" ::: "memory"); }
    }
};
struct EpiMergeSlab {
    static constexpr bool PERM = false, AFTER_DRAIN = false, MIDHOOK = false;
    const bf16_t* GA; const bf16_t* GB; float* slab; int ntsub;
    __device__ __forceinline__ void operator()(const f32x4 (&acc)[2][2][4][2], const Unit& u, int wr, int wc, int fr, int fq) const {
        const int slice = u.kt0 / ntsub;
        const bf16_t* G = (slice >= 4 ? GB : GA) + (size_t)NP * D;
        float* C = slab + (size_t)slice * ((size_t)NS * D);
        const int row0 = (u.pm - NP / BM) * BM + wr * 64 + fr, col0 = u.pn * BM + wc * 32 + 4 * fq;
#pragma unroll
        for (int ai = 0; ai < 2; ++ai)
#pragma unroll
            for (int m = 0; m < 4; ++m) { const size_t ro = (size_t)(row0 + ai * HALF + m * 16) * D + col0;
#pragma unroll
                for (int bj = 0; bj < 2; ++bj)
#pragma unroll
                    for (int n = 0; n < 2; ++n) { const size_t o = ro + bj * HALF + n * 16;
                        const u32x2 gw = *(const u32x2*)(G + o); const f32x4 g = (f32x4){bfl(gw.x), bfh(gw.x), bfl(gw.y), bfh(gw.y)};
                        *(f32x4*)(C + o) = g * acc[ai][bj][m][n]; }
                asm volatile("" ::: "memory"); }
    }
};

struct EpiT16 {
    static constexpr bool PERM = true, AFTER_DRAIN = false, MIDHOOK = false;
    bf16_t* O;
    __device__ __forceinline__ void operator()(const f32x4 (&acc)[2][2][4][2], const Unit& u, int wr, int wc, int fr, int fq) const {
        const int row0 = u.pm * BM + wr * 64 + fr, col0 = u.pn * BM + wc * 32 + 8 * fq;
#pragma unroll
        for (int ai = 0; ai < 2; ++ai)
#pragma unroll
            for (int m = 0; m < 4; ++m) { bf16_t* rowp = O + (size_t)(row0 + ai * HALF + m * 16) * D + col0;
#pragma unroll
                for (int bj = 0; bj < 2; ++bj) { const f32x4 v0 = acc[ai][bj][m][0], v1 = acc[ai][bj][m][1];
                    u32x4 w; w.x = cvt_pk_bf16(v0[0], v0[1]); w.y = cvt_pk_bf16(v0[2], v0[3]); w.z = cvt_pk_bf16(v1[0], v1[1]); w.w = cvt_pk_bf16(v1[2], v1[3]);
                    *(u32x4*)(rowp + bj * HALF) = w; } }
    }
};
struct EpiPle16 {
    static constexpr bool PERM = true, AFTER_DRAIN = false, MIDHOOK = false;
    const bf16_t* PUP; bf16_t* T;
    __device__ __forceinline__ void operator()(const f32x4 (&acc)[2][2][4][2], const Unit& u, int wr, int wc, int fr, int fq) const {
        const int row0 = u.pm * BM + wr * 64 + fr, col0 = u.pn * BM + wc * 32 + 8 * fq;
#pragma unroll
        for (int ai = 0; ai < 2; ++ai)
#pragma unroll
            for (int m = 0; m < 4; ++m) { const size_t ro = (size_t)(row0 + ai * HALF + m * 16) * D + col0;
#pragma unroll
                for (int bj = 0; bj < 2; ++bj) { const u32x4 pw = *(const u32x4*)(PUP + ro + bj * HALF); f32x4 p0, p1; unpack8(pw, p0, p1);
                    const f32x4 v0 = sigm4(acc[ai][bj][m][0]) * p0, v1 = sigm4(acc[ai][bj][m][1]) * p1;
                    u32x4 w; w.x = cvt_pk_bf16(v0[0], v0[1]); w.y = cvt_pk_bf16(v0[2], v0[3]); w.z = cvt_pk_bf16(v1[0], v1[1]); w.w = cvt_pk_bf16(v1[2], v1[3]);
                    *(u32x4*)(T + ro + bj * HALF) = w; }
                asm volatile("" ::: "memory"); }
    }
};
template <class Epi, class Sched, bool ALIGN_EPI = false, bool SP2 = false>
__device__ __forceinline__ void gemm_phase(PG8_LAS unsigned char* lds, const Gemm g, const Sched& S, const Epi& E) {
    int tid_ = threadIdx.x; asm volatile("" : "+v"(tid_));
    const int tid = tid_, wid = __builtin_amdgcn_readfirstlane(tid >> 6), lane = tid & 63, wr = wid >> 2, wc = wid & 3, fr = lane & 15, fq = lane >> 4;
    const int K = g.K, nt = __builtin_amdgcn_readfirstlane(g.nt);
    unsigned voffA[2], voffB[2];
#pragma unroll
    for (int i = 0; i < 2; ++i) { int R, C; stage_rc(tid * 16 + i * 8192, R, C); const int Rb = Epi::PERM ? ((R & ~31) + perm32(R & 31)) : R;
        voffA[i] = (unsigned)(R * K + C) * 2u; voffB[i] = (unsigned)(Rb * K + C) * 2u; }
    const size_t kstep = (size_t)(BK * 2);
    const size_t hstep = (size_t)HALF * K * 2;
    const size_t tstep = 2 * hstep;
    const unsigned ldsw = (unsigned)wid * 1024u;
    const int aoff = lds_byte(wr * 64 + fr, fq * 8), boff = lds_byte(wc * 32 + fr, fq * 8);
#define PG8_SA(b, h) (((b) * 2 + (h)) * HTB)
#define PG8_SB(b, h) ((4 + (b) * 2 + (h)) * HTB)
#define PG8_STAGE(bufoff, gbase, voff) do { _Pragma("unroll") for (int _i = 0; _i < 2; ++_i) \
        __builtin_amdgcn_global_load_lds((const unsigned*)((const char*)(gbase) + (voff)[_i]), (PG8_LAS unsigned*)(lds + (bufoff) + ldsw + _i * 8192), 16, 0, 0); } while (0)
#define PG8_LDA(dst, b, h) do { _Pragma("unroll") for (int m = 0; m < 4; ++m) _Pragma("unroll") for (int k = 0; k < 2; ++k) dst[m][k] = *(const PG8_LAS bf16x8*)(lds + PG8_SA(b, h) + aoff + m * 2048 + k * 1024); } while (0)
#define PG8_LDB(dst, b, h) do { _Pragma("unroll") for (int n = 0; n < 2; ++n) _Pragma("unroll") for (int k = 0; k < 2; ++k) dst[n][k] = *(const PG8_LAS bf16x8*)(lds + PG8_SB(b, h) + boff + n * 2048 + k * 1024); } while (0)
#define PG8_MMA(ai, bj, At, Bt) do { __builtin_amdgcn_s_setprio(1); _Pragma("unroll") for (int m = 0; m < 4; ++m) _Pragma("unroll") for (int n = 0; n < 2; ++n) _Pragma("unroll") for (int k = 0; k < 2; ++k) \
        acc[ai][bj][m][n] = __builtin_amdgcn_mfma_f32_16x16x32_bf16(Bt[n][k], At[m][k], acc[ai][bj][m][n], 0, 0, 0); __builtin_amdgcn_s_setprio(0); } while (0)
#define PG8_WAIT_V(n) asm volatile("s_waitcnt vmcnt(" #n ")" ::: "memory")
#define PG8_WAIT_L(n) asm volatile("s_waitcnt lgkmcnt(" #n ")" ::: "memory")
#define PG8_BAR __builtin_amdgcn_s_barrier()
#define PG8_SCHED __builtin_amdgcn_sched_barrier(0)
    Unit cur, nxt; int ui = 0;
    if (!S.next(0, cur)) return;
    f32x4 acc[2][2][4][2];
#pragma unroll
    for (int a = 0; a < 2; ++a)
#pragma unroll
        for (int b = 0; b < 2; ++b)
#pragma unroll
            for (int m = 0; m < 4; ++m)
#pragma unroll
                for (int n = 0; n < 2; ++n) acc[a][b][m][n] = (f32x4){0.f, 0.f, 0.f, 0.f};
    bf16x8 At[4][2], B0[2][2], B1[2][2];
    const char* cA = (const char*)g.A + (size_t)cur.pm * tstep + (size_t)cur.kt0 * kstep; const char* cB = (const char*)g.Bt + (size_t)cur.pn * tstep + (size_t)cur.kt0 * kstep;
    S.a_ready(cur);
    if constexpr (SP2) {
        PG8_STAGE(PG8_SB(0, 0), cB, voffB); PG8_STAGE(PG8_SB(0, 1), cB + hstep, voffB); PG8_STAGE(PG8_SA(0, 0), cA, voffA); PG8_STAGE(PG8_SA(0, 1), cA + hstep, voffA);
        if (wr == 1) PG8_BAR;
        PG8_WAIT_V(2); PG8_BAR;
        PG8_STAGE(PG8_SB(1, 0), cB + kstep, voffB); PG8_STAGE(PG8_SA(1, 0), cA + kstep, voffA); PG8_STAGE(PG8_SB(1, 1), cB + hstep + kstep, voffB);
        PG8_WAIT_V(6); PG8_BAR;
    } else {
        PG8_STAGE(PG8_SB(0, 0), cB, voffB); PG8_STAGE(PG8_SA(0, 0), cA, voffA); PG8_STAGE(PG8_SB(0, 1), cB + hstep, voffB); PG8_STAGE(PG8_SA(0, 1), cA + hstep, voffA);
        if (wr == 1) PG8_BAR;
        PG8_WAIT_V(4); PG8_BAR;
        PG8_STAGE(PG8_SB(1, 0), cB + kstep, voffB); PG8_STAGE(PG8_SA(1, 0), cA + kstep, voffA); PG8_STAGE(PG8_SB(1, 1), cB + hstep + kstep, voffB);
        PG8_WAIT_V(6); PG8_BAR;
    }
    for (;;) {
        const bool has_next = S.next(ui + 1, nxt);
        const char* nA = has_next ? (const char*)g.A + (size_t)nxt.pm * tstep + (size_t)nxt.kt0 * kstep : cA; const char* nB = has_next ? (const char*)g.Bt + (size_t)nxt.pn * tstep + (size_t)nxt.kt0 * kstep : cB;
        for (int t = 0; t < nt; t += 2) {
            if constexpr (Epi::MIDHOOK) { if (t == (nt >> 1)) E.mid(acc, cur, wr, wc, fr, fq); }
            const bool last = (t == nt - 2);
            const char* a1 = cA + (size_t)(t + 1) * kstep;
            const char* a2 = last ? nA : cA + (size_t)(t + 2) * kstep; const char* b2 = last ? nB : cB + (size_t)(t + 2) * kstep;
            const char* a3 = a2 + kstep; const char* b3 = b2 + kstep;
            if (last && has_next) S.a_ready(nxt);
            if constexpr (SP2) {
            PG8_LDB(B0, 0, 0); PG8_LDB(B1, 0, 1); PG8_SCHED; PG8_LDA(At, 0, 0); PG8_STAGE(PG8_SA(1, 1), a1 + hstep, voffA);
            PG8_WAIT_V(8); PG8_WAIT_L(0); PG8_BAR; PG8_MMA(0, 0, At, B0); PG8_MMA(0, 1, At, B1); PG8_BAR; PG8_SCHED;
            PG8_LDA(At, 0, 1); PG8_STAGE(PG8_SB(0, 0), b2, voffB); PG8_STAGE(PG8_SB(0, 1), b2 + hstep, voffB); PG8_STAGE(PG8_SA(0, 0), a2, voffA);
            PG8_WAIT_V(8); PG8_WAIT_L(0); PG8_BAR; PG8_MMA(1, 0, At, B0); PG8_MMA(1, 1, At, B1); PG8_BAR; PG8_SCHED;
            PG8_LDB(B0, 1, 0); PG8_LDB(B1, 1, 1); PG8_SCHED; PG8_LDA(At, 1, 0); PG8_STAGE(PG8_SA(0, 1), a2 + hstep, voffA);
            PG8_WAIT_V(8); PG8_WAIT_L(0); PG8_BAR; PG8_MMA(0, 0, At, B0); PG8_MMA(0, 1, At, B1); PG8_BAR; PG8_SCHED;
            PG8_LDA(At, 1, 1); PG8_STAGE(PG8_SB(1, 0), b3, voffB); PG8_STAGE(PG8_SB(1, 1), b3 + hstep, voffB); PG8_STAGE(PG8_SA(1, 0), a3, voffA);
            PG8_WAIT_V(8); PG8_WAIT_L(0); PG8_BAR; PG8_MMA(1, 0, At, B0); PG8_MMA(1, 1, At, B1); PG8_BAR; PG8_SCHED;
            } else {
            PG8_LDB(B0, 0, 0); PG8_SCHED; PG8_LDA(At, 0, 0); PG8_STAGE(PG8_SA(1, 1), a1 + hstep, voffA);
            PG8_WAIT_L(8); PG8_BAR; PG8_WAIT_L(0); PG8_MMA(0, 0, At, B0); PG8_BAR; PG8_SCHED;
            PG8_LDB(B1, 0, 1); PG8_STAGE(PG8_SB(0, 0), b2, voffB);
            PG8_BAR; PG8_WAIT_L(0); PG8_MMA(0, 1, At, B1); PG8_BAR;
            PG8_LDA(At, 0, 1); PG8_STAGE(PG8_SA(0, 0), a2, voffA);
            PG8_BAR; PG8_WAIT_L(0); PG8_MMA(1, 0, At, B0); PG8_BAR; PG8_SCHED;
            PG8_STAGE(PG8_SB(0, 1), b2 + hstep, voffB);
            PG8_WAIT_V(6); PG8_BAR; PG8_MMA(1, 1, At, B1); PG8_BAR;
            PG8_LDB(B0, 1, 0); PG8_SCHED; PG8_LDA(At, 1, 0); PG8_STAGE(PG8_SA(0, 1), a2 + hstep, voffA);
            PG8_WAIT_L(8); PG8_BAR; PG8_WAIT_L(0); PG8_MMA(0, 0, At, B0); PG8_BAR; PG8_SCHED;
            PG8_LDB(B1, 1, 1); PG8_STAGE(PG8_SB(1, 0), b3, voffB);
            PG8_BAR; PG8_WAIT_L(0); PG8_MMA(0, 1, At, B1); PG8_BAR;
            PG8_LDA(At, 1, 1); PG8_STAGE(PG8_SA(1, 0), a3, voffA);
            PG8_BAR; PG8_WAIT_L(0); PG8_MMA(1, 0, At, B0); PG8_BAR; PG8_SCHED;
            PG8_STAGE(PG8_SB(1, 1), b3 + hstep, voffB);
            PG8_WAIT_V(6); PG8_BAR; PG8_MMA(1, 1, At, B1); PG8_BAR;
            }
        }
        if constexpr (ALIGN_EPI) { if (wr == 0) PG8_BAR; }
        if constexpr (!Epi::AFTER_DRAIN) { E(acc, cur, wr, wc, fr, fq); S.done(cur); } else { if (has_next) { E(acc, cur, wr, wc, fr, fq); S.done(cur); } }
        if (!has_next) break;
#pragma unroll
        for (int a = 0; a < 2; ++a)
#pragma unroll
            for (int b = 0; b < 2; ++b)
#pragma unroll
                for (int m = 0; m < 4; ++m)
#pragma unroll
                    for (int n = 0; n < 2; ++n) acc[a][b][m][n] = (f32x4){0.f, 0.f, 0.f, 0.f};
        cur = nxt; cA = nA; cB = nB; ++ui;
        if constexpr (ALIGN_EPI) { if (wr == 1) PG8_BAR; }
    }
    PG8_WAIT_V(0);
    if constexpr (!ALIGN_EPI) { if (wr == 0) PG8_BAR; }
    PG8_BAR;
    if constexpr (Epi::AFTER_DRAIN) { E.fused(acc, cur, wr, wc, fr, fq, lds, wid, lane); S.done(cur); }
#undef PG8_SA
#undef PG8_SB
#undef PG8_STAGE
#undef PG8_LDA
#undef PG8_LDB
#undef PG8_MMA
#undef PG8_WAIT_V
#undef PG8_WAIT_L
#undef PG8_BAR
#undef PG8_SCHED
}
}

constexpr int NWAVES = 8;
#ifndef MK_SINGLE
#define MK_SINGLE 1
#endif
constexpr int N_PHASES = 17;

enum { I_XP = 0, I_XS, I_PP, I_PS, I_SCONV, I_SC, I_SN, I_SM, I_G1PRE, I_W1G, I_W1U, I_W1D, I_G1POST, I_GMIXPRE, I_WIN, I_WCONV, I_BCONV, I_BI, I_BF, I_GHEAD, I_WAOUT,
       I_GLN, I_BLN, I_WSP, I_BSP, I_WBOUT, I_WO, I_GMIXPOST, I_G2PRE, I_W2G, I_W2U, I_W2D, I_G2POST, I_GPLEPRE, I_WPG, I_WPU, I_GPLEPOST, N_IN };
constexpr size_t O_Y = 0, O_CONVP = (size_t)M * D, O_CP = O_CONVP + 4 * 3 * 2048, O_NP = O_CP + (size_t)16 * 256 * 512, O_MP = O_NP + 16 * 256, O_CONVS = O_MP + 16,
                 O_CS = O_CONVS + (size_t)128 * 3 * 2048, O_NS = O_CS + (size_t)512 * 256 * 512, O_MS = O_NS + 512 * 256, O_VS = O_MS + 512, O_END = O_VS + (size_t)NS * D;
static_assert(O_END == 89027088, "output size");

constexpr size_t MiB = 1u << 20;
constexpr size_t WS_CTL = 0, CTL_ZERO_BYTES = 1 * MiB;
constexpr size_t WS_W1 = 1 * MiB, WS_W1D = WS_W1 + 44 * MiB, WS_WIN = WS_W1D + 22 * MiB, WS_WAB = WS_WIN + 57 * MiB, WS_WO = WS_WAB + 16 * MiB, WS_WPG = WS_WO + 8 * MiB,
                 WS_WPU = WS_WPG + 8 * MiB, WS_W2 = WS_WPU + 1 * MiB, WS_W2D = WS_W2 + 44 * MiB, WS_WGT = WS_W2D + 22 * MiB, WS_PB = WS_WGT + 1 * MiB, WS_XN = WS_PB + 5 * MiB,
                 WS_HFF = WS_XN + 34 * MiB, WS_T32 = WS_HFF + 94 * MiB, WS_H = WS_T32 + 68 * MiB, WS_Z = WS_H + 68 * MiB, WS_QC = WS_Z + 238 * MiB, WS_KC = WS_QC + 17 * MiB,
                 WS_GATES = WS_KC + 17 * MiB, WS_STAT = WS_GATES + 1 * MiB, WS_HRAW = WS_STAT + 3 * MiB, WS_AB = WS_HRAW + 68 * MiB, WS_MIX = WS_AB + 68 * MiB, WS_SLAB = WS_MIX + 34 * MiB, WS_SCT = WS_SLAB + 32 * MiB, WS_SRAW = WS_SCT + 1 * MiB, WS_DENINV = WS_SRAW + 4 * MiB, WS_END = WS_DENINV + 1 * MiB;
constexpr size_t WS_PUP = WS_Z;
static_assert((size_t)11264 * 2048 * 2 == 44 * MiB && (size_t)M * D * 2 == 34 * MiB && (size_t)M * D * 4 == 68 * MiB && (size_t)M * FF * 2 <= 94 * MiB && (size_t)NZG * D * 2 == 57 * MiB, "ws map");
static_assert(WS_END <= 1024 * MiB, "workspace");
constexpr int CW_BAR = 4096, CW_QUEUE = 2048, CW_MIXCNT = 2176;

constexpr int LDS_PHASE_BYTES = 155648;
constexpr int MISC_OFF = LDS_PHASE_BYTES;
constexpr int LDS_BYTES = LDS_PHASE_BYTES + 256;

#define GAS __attribute__((address_space(1)))
#define LAS __attribute__((address_space(3)))
typedef unsigned short bf16;
typedef unsigned v4u __attribute__((ext_vector_type(4)));
typedef unsigned v2u __attribute__((ext_vector_type(2)));
typedef float f32x4 __attribute__((ext_vector_type(4)));
typedef short bf16x8 __attribute__((ext_vector_type(8)));
typedef GAS unsigned gu32;
#define RLX_AGENT __ATOMIC_RELAXED, __HIP_MEMORY_SCOPE_AGENT
#define LDS_WAIT() asm volatile("s_waitcnt lgkmcnt(0)" ::: "memory")
#define VM_WAIT() asm volatile("s_waitcnt vmcnt(0)" ::: "memory")
__device__ __forceinline__ unsigned f2bf(float f) { unsigned u = __builtin_bit_cast(unsigned, f); return (u + 0x7fffu + ((u >> 16) & 1u)) >> 16; }
__device__ __forceinline__ unsigned pk2(float lo, float hi) { return f2bf(lo) | (f2bf(hi) << 16); }
__device__ __forceinline__ float bflo(unsigned w) { return __uint_as_float(w << 16); }
__device__ __forceinline__ float bfhi(unsigned w) { return __uint_as_float(w & 0xffff0000u); }
__device__ __forceinline__ float bf2f(bf16 b) { return __uint_as_float((unsigned)b << 16); }
__device__ __forceinline__ float sigmf(float x) { return __builtin_amdgcn_rcpf(1.0f + __expf(-x)); }
__device__ __forceinline__ float wave_sum(float v) {
#pragma unroll
    for (int o = 1; o < 64; o <<= 1) v += __shfl_xor(v, o);
    return v;
}
__device__ __forceinline__ float dot4(f32x4 a, f32x4 b) { return (a[0] * b[0] + a[1] * b[1]) + (a[2] * b[2] + a[3] * b[3]); }

#define XB_TMO      128
#define XB_XCNT(j)  (256  + 64 * (j))
#define XB_XSUB(j)  (1280 + 64 * (j))
#define XB_XGEN(j)  (2304 + 64 * (j))
#define XB_TOP      3328
#define XB_TOPGEN   3392
#define XCD_BAR_WORDS 3456
#define XB_SPIN_CAP (1u << 18)

__device__ __forceinline__ unsigned xb_ld(unsigned* p)              { return __hip_atomic_load(p, __ATOMIC_RELAXED, __HIP_MEMORY_SCOPE_AGENT); }
__device__ __forceinline__ unsigned xb_add(unsigned* p, unsigned v) { return __hip_atomic_fetch_add(p, v, __ATOMIC_RELAXED, __HIP_MEMORY_SCOPE_AGENT); }
__device__ __forceinline__ unsigned xb_xcc_id() { return (unsigned)__builtin_amdgcn_s_getreg((3 << 11) | 20) & 0xFu; }
#define XB_SPIN(cond, bar) do { unsigned _sp = 0; while (cond) { __builtin_amdgcn_s_sleep(1); \
    if ((++_sp & 255u) == 0u) { if (xb_ld(&(bar)[XB_TMO])) break; if (_sp > XB_SPIN_CAP) { atomicAdd(&(bar)[XB_TMO], 1u); break; } } } } while (0)

struct XcdBarrier {
    unsigned* bar; unsigned x;
    volatile LAS unsigned* st;
};

__device__ __forceinline__ XcdBarrier xcd_barrier_post(unsigned* bar, volatile LAS unsigned* st) {
    XcdBarrier b; b.bar = bar; b.x = xb_xcc_id(); b.st = st;
    if (threadIdx.x == 0) (void)xb_add(&bar[XB_XCNT(b.x)], 1u);
    return b;
}
__device__ __forceinline__ void xcd_barrier_complete(unsigned* bar, unsigned x, unsigned& nloc, unsigned& nx) {
    const unsigned G = gridDim.x * gridDim.y * gridDim.z;
    unsigned sum, cnt, mine, sp = 0u;
    for (;;) {
        sum = 0u; cnt = 0u; mine = 0u;
#pragma unroll
        for (unsigned j = 0; j < 16; ++j) { const unsigned c = xb_ld(&bar[XB_XCNT(j)]); sum += c; cnt += (c > 0u) ? 1u : 0u; mine = (j == x) ? c : mine; }
        if (sum == G) break;
        __builtin_amdgcn_s_sleep(1);
        if ((++sp & 255u) == 0u) { if (xb_ld(&bar[XB_TMO])) break; if (sp > XB_SPIN_CAP) { atomicAdd(&bar[XB_TMO], 1u); break; } }
    }
    nloc = mine > 0u ? mine : 1u; nx = cnt > 0u ? cnt : 1u;
}

__device__ __forceinline__ void xcd_barrier(const XcdBarrier& b) {
    asm volatile("s_waitcnt vmcnt(0)" ::: "memory");
    __syncthreads();
    if (threadIdx.x == 0) {
        unsigned* bar = b.bar;
        __builtin_amdgcn_s_waitcnt(0);
        unsigned nloc = b.st[0], nx = b.st[1];
        if (nloc == 0u) { xcd_barrier_complete(bar, b.x, nloc, nx); b.st[0] = nloc; b.st[1] = nx; }
        const unsigned old = xb_add(&bar[XB_XSUB(b.x)], 1u);
        const unsigned gen = old / nloc;
        if (old + 1u == (gen + 1u) * nloc) {
            __builtin_amdgcn_fence(__ATOMIC_RELEASE, "agent");
            asm volatile("s_waitcnt vmcnt(0)" ::: "memory");
            const unsigned og = xb_add(&bar[XB_TOP], 1u);
            __builtin_amdgcn_fence(__ATOMIC_ACQUIRE, "agent");
            if (og + 1u == (gen + 1u) * nx) xb_add(&bar[XB_TOPGEN], 1u);
            else XB_SPIN(xb_ld(&bar[XB_TOPGEN]) == gen, bar);
        } else {
            __builtin_amdgcn_fence(__ATOMIC_ACQUIRE, "agent");
            XB_SPIN(xb_ld(&bar[XB_TOPGEN]) == gen, bar);
        }
        asm volatile("s_waitcnt vmcnt(0)" ::: "memory");
    }
    __syncthreads();
}

struct Args { const float* in[N_IN]; float* out; unsigned char* ws; int ph_lo, ph_hi; };
struct Frame {
    LAS unsigned char* lds;
    volatile LAS unsigned* MISC;
    int tid, lane, wave, vcu, G;
    unsigned char* ws; float* out;
};
#define WSP(T, off) ((T*)(F.ws + (off)))

__device__ __forceinline__ void p0_transpose_item(const float* W, int ldw, int K, bf16* WT, int mode, int nblk, LAS float* scr, int item, int lane, int ldt = 0) {
    if (ldt == 0) ldt = K;
    asm volatile("" : "+v"(lane));
    const int kb = item / nblk, nb = item % nblk, k0 = 64 * kb, n0 = 32 * nb;
    { float wv[32];
      const float* wp = W + (size_t)(k0 + (lane >> 5)) * ldw + n0 + (lane & 31);
#pragma unroll
      for (int i = 0; i < 32; ++i) wv[i] = wp[(size_t)(2 * i) * ldw];
#pragma unroll
      for (int i = 0; i < 32; ++i) scr[(2 * i + (lane >> 5)) * 33 + (lane & 31)] = wv[i]; }
    LDS_WAIT(); asm volatile("" ::: "memory");
    const int c = lane & 7;
    const int r0 = (mode == 0) ? n0 : (256 * (n0 >> 7) + (n0 & 127) + (mode == 2 ? 128 : 0));
#pragma unroll
    for (int j = 0; j < 4; ++j) { const int n = (lane >> 3) + 8 * j; const LAS float* s = scr + (8 * c) * 33 + n;
        v4u o; o.x = pk2(s[0 * 33], s[1 * 33]); o.y = pk2(s[2 * 33], s[3 * 33]); o.z = pk2(s[4 * 33], s[5 * 33]); o.w = pk2(s[6 * 33], s[7 * 33]);
        *(GAS v4u*)(WT + (size_t)(r0 + n) * ldt + k0 + 8 * c) = o; }
    LDS_WAIT(); asm volatile("" ::: "memory");
}
__device__ __forceinline__ const float* xrow(const Args& a, int r) { return r < NP ? a.in[I_XP] + (size_t)r * D : a.in[I_XS] + (size_t)(r - NP) * D; }

template <int MODE, bool GATES, int TSRC = 0>
__device__ __forceinline__ void rowwise(Frame& F, const Args& a, const bf16* RES, const bf16* T, const float* gpost, float sc, const float* gpre, bf16* Hout, bf16* XN, float* Yout, int nslab = 0, const bf16* PUP = nullptr) {
    const int gw = F.vcu * NWAVES + F.wave, NGW = F.G * NWAVES, lane = F.lane;
    const LAS f32x4* wgL = (const LAS f32x4*)F.lds;
    f32x4 gpo[8], gpr[8];
#pragma unroll
    for (int j = 0; j < 8; ++j) { gpo[j] = (MODE != 0) ? ((const GAS f32x4*)gpost)[lane + 64 * j] : (f32x4){0.f, 0.f, 0.f, 0.f}; gpr[j] = (MODE != 2) ? ((const GAS f32x4*)gpre)[lane + 64 * j] : (f32x4){0.f, 0.f, 0.f, 0.f}; }
    for (int r = gw; r < M; r += NGW) {
        f32x4 v[8];
        if (RES) { const GAS v2u* rp = (const GAS v2u*)(RES + (size_t)r * D) + lane;
#pragma unroll
            for (int j = 0; j < 8; ++j) { const v2u w = rp[64 * j]; v[j] = (f32x4){bflo(w.x), bfhi(w.x), bflo(w.y), bfhi(w.y)}; } }
        else { const GAS f32x4* rp = (const GAS f32x4*)xrow(a, r) + lane;
#pragma unroll
            for (int j = 0; j < 8; ++j) v[j] = rp[64 * j]; }
        if (MODE != 0) {
            const GAS v2u* tp = (const GAS v2u*)(T + (size_t)r * D) + lane;
            f32x4 t[8]; float ss = 0.f;
            if (TSRC != 0 && r >= NP) {
                const GAS f32x4* sp = (const GAS f32x4*)(WSP(float, WS_SLAB) + (size_t)(r - NP) * D) + lane;
#pragma unroll
                for (int j = 0; j < 8; ++j) t[j] = sp[64 * j];
                _Pragma("unroll 4") for (int s = 1; s < nslab; ++s) { sp += (size_t)NS * D / 4;
#pragma unroll
                    for (int j = 0; j < 8; ++j) t[j] += sp[64 * j]; }
                if (TSRC == 2) { const GAS v2u* pp = (const GAS v2u*)(PUP + (size_t)r * D) + lane;
#pragma unroll
                    for (int j = 0; j < 8; ++j) { const v2u pw = pp[64 * j]; const f32x4 p = (f32x4){bflo(pw.x), bfhi(pw.x), bflo(pw.y), bfhi(pw.y)}; t[j] = (f32x4){sigmf(t[j][0]), sigmf(t[j][1]), sigmf(t[j][2]), sigmf(t[j][3])} * p; } }
#pragma unroll
                for (int j = 0; j < 8; ++j) ss += dot4(t[j], t[j]);
            } else {
#pragma unroll
                for (int j = 0; j < 8; ++j) { const v2u tw = tp[64 * j]; t[j] = (f32x4){bflo(tw.x), bfhi(tw.x), bflo(tw.y), bfhi(tw.y)}; ss += dot4(t[j], t[j]); }
            }
            ss = wave_sum(ss);
            const float rs = sc * (1.0f / sqrtf(ss * (1.0f / D) + EPS));
#pragma unroll
            for (int j = 0; j < 8; ++j) { const f32x4 g = gpo[j]; v[j] = v[j] + (t[j] * rs) * g;
                if (MODE == 2) ((GAS f32x4*)(Yout + (size_t)r * D))[lane + 64 * j] = v[j];
                else { v2u w; w.x = pk2(v[j][0], v[j][1]); w.y = pk2(v[j][2], v[j][3]); ((GAS v2u*)(Hout + (size_t)r * D))[lane + 64 * j] = w;
                       v[j] = (f32x4){bflo(w.x), bfhi(w.x), bflo(w.y), bfhi(w.y)}; } }
        }
        if (MODE != 2) {
            float ss = 0.f;
#pragma unroll
            for (int j = 0; j < 8; ++j) ss += dot4(v[j], v[j]);
            ss = wave_sum(ss);
            const float rs = 1.0f / sqrtf(ss * (1.0f / D) + EPS);
            float ga[8];
#pragma unroll
            for (int c = 0; c < 8; ++c) ga[c] = 0.f;
            GAS v2u* op = (GAS v2u*)(XN + (size_t)r * D) + lane;
#pragma unroll
            for (int j = 0; j < 8; ++j) { const f32x4 g = gpr[j]; const f32x4 xn = (v[j] * rs) * g;
                v2u w; w.x = pk2(xn[0], xn[1]); w.y = pk2(xn[2], xn[3]); op[64 * j] = w;
 }
        }
    }
}

constexpr int IT_FG = (D / 64) * (FF / 32), IT_FD = (FF / 64) * (D / 32), IT_INA = (D / 64) * (6144 / 32), IT_INB = (D / 64) * (8192 / 32), IT_SQ = (D / 64) * (D / 32), IT_PU = (DPLE / 64) * (D / 32);
constexpr int NITEMS_EARLY = 2 * IT_FG + IT_FD + IT_INA + IT_INB;
constexpr int NITEMS_LATE = 4 * IT_SQ + IT_PU + 2 * IT_FG + IT_FD;
__device__ __forceinline__ void transpose_early(const Args& a, Frame& F, LAS float* scr, int r) {
    bf16 *W1 = WSP(bf16, WS_W1), *W1D = WSP(bf16, WS_W1D), *WIN = WSP(bf16, WS_WIN);
    if (r < IT_FG) { p0_transpose_item(a.in[I_W1G], FF, D, W1, 1, FF / 32, scr, r, F.lane); return; } r -= IT_FG;
    if (r < IT_FG) { p0_transpose_item(a.in[I_W1U], FF, D, W1, 2, FF / 32, scr, r, F.lane); return; } r -= IT_FG;
    if (r < IT_FD) { p0_transpose_item(a.in[I_W1D], D, FF, W1D, 0, D / 32, scr, r, F.lane); return; } r -= IT_FD;
    if (r < IT_INA) { p0_transpose_item(a.in[I_WIN], 14344, D, WIN, 0, 6144 / 32, scr, r, F.lane); return; } r -= IT_INA;
    p0_transpose_item(a.in[I_WIN] + 6152, 14344, D, WIN + (size_t)6144 * D, 0, 8192 / 32, scr, r, F.lane);
}
__device__ __forceinline__ void transpose_late(const Args& a, Frame& F, LAS float* scr, int r) {
    bf16 *WAB = WSP(bf16, WS_WAB), *WO = WSP(bf16, WS_WO), *WPG = WSP(bf16, WS_WPG), *WPU = WSP(bf16, WS_WPU), *W2 = WSP(bf16, WS_W2), *W2D = WSP(bf16, WS_W2D);
    if (r < IT_SQ) { p0_transpose_item(a.in[I_WAOUT], D, D, WAB, 0, D / 32, scr, r, F.lane, 2 * D); return; } r -= IT_SQ;
    if (r < IT_SQ) { p0_transpose_item(a.in[I_WBOUT], D, D, WAB + D, 0, D / 32, scr, r, F.lane, 2 * D); return; } r -= IT_SQ;
    if (r < IT_SQ) { p0_transpose_item(a.in[I_WO], D, D, WO, 0, D / 32, scr, r, F.lane); return; } r -= IT_SQ;
    if (r < IT_SQ) { p0_transpose_item(a.in[I_WPG], D, D, WPG, 0, D / 32, scr, r, F.lane); return; } r -= IT_SQ;
    if (r < IT_PU) { p0_transpose_item(a.in[I_WPU], D, DPLE, WPU, 0, D / 32, scr, r, F.lane); return; } r -= IT_PU;
    if (r < IT_FG) { p0_transpose_item(a.in[I_W2G], FF, D, W2, 1, FF / 32, scr, r, F.lane); return; } r -= IT_FG;
    if (r < IT_FG) { p0_transpose_item(a.in[I_W2U], FF, D, W2, 2, FF / 32, scr, r, F.lane); return; } r -= IT_FG;
    p0_transpose_item(a.in[I_W2D], D, FF, W2D, 0, D / 32, scr, r, F.lane);
}
template <bool LATE = false>
__device__ __forceinline__ void transpose_tail(Frame& F, const Args& a, int bx, int lo, int first, int count) {
    if (F.G != 256 || bx < lo) return;
    LAS float* scr = (LAS float*)(F.lds + F.wave * 16384);
    for (int j = (bx - lo) * NWAVES + F.wave; j < count; j += (F.G - lo) * NWAVES) { if (LATE) transpose_late(a, F, scr, first + j); else transpose_early(a, F, scr, first + j); }
}
__device__ __forceinline__ void p0_prologue(Frame& F, const Args& a) {
    LAS float* scr = (LAS float*)(F.lds + F.wave * 16384);
    const int gw = F.vcu * NWAVES + F.wave, NGW = F.G * NWAVES;
    for (int it = gw; it < (F.G == 256 ? 2 * IT_FG : NITEMS_EARLY); it += NGW) transpose_early(a, F, scr, it);
    { bf16* WG = WSP(bf16, WS_WIN) + (size_t)NZ * D; const int gt = F.vcu * (NWAVES * 64) + F.tid, NT = F.G * NWAVES * 64;
      for (int i = gt; i < 256 * D; i += NT) { const int c = i >> 11, k = i & (D - 1); WG[i] = c < 8 ? (bf16)f2bf(a.in[I_WIN][(size_t)k * 14344 + 6144 + c]) : (bf16)0; } }
    { bf16* PB = WSP(bf16, WS_PB);
      for (int r = gw; r < M; r += NGW) { const float* pr = r < NP ? a.in[I_PP] + (size_t)r * DPLE : a.in[I_PS] + (size_t)(r - NP) * DPLE;
          const f32x4 v = ((const GAS f32x4*)pr)[F.lane]; v2u w; w.x = pk2(v[0], v[1]); w.y = pk2(v[2], v[3]); ((GAS v2u*)(PB + (size_t)r * DPLE))[F.lane] = w; } }
    rowwise<0, false>(F, a, nullptr, nullptr, nullptr, 0.f, a.in[I_G1PRE], nullptr, WSP(bf16, WS_XN), nullptr);
}

__device__ __forceinline__ void conv_silu_all(Frame& F, const Args& a) {
    const bf16* Z0 = WSP(bf16, WS_Z); bf16* QC = WSP(bf16, WS_QC); bf16* KC = WSP(bf16, WS_KC);
    const float* wc = a.in[I_WCONV]; const float* bc = a.in[I_BCONV]; const float* sconv = a.in[I_SCONV];
    const int gt = F.vcu * (NWAVES * 64) + F.tid, NT = F.G * NWAVES * 64;
    for (int it = gt + NP * 256; it < M * 256; it += NT) {
        const int r = it >> 8, col = (it & 255) * 8;
        float y[8];
        { const f32x4 b0 = *(const GAS f32x4*)(bc + col), b1 = *(const GAS f32x4*)(bc + col + 4);
          y[0] = b0[0]; y[1] = b0[1]; y[2] = b0[2]; y[3] = b0[3]; y[4] = b1[0]; y[5] = b1[1]; y[6] = b1[2]; y[7] = b1[3]; }
        int t, bsm = 0;
        if (r < NP) t = r & (SEQ - 1); else { const int s = r - NP; bsm = s >> 2; t = s & 3; }
#pragma unroll
        for (int j = 0; j < 4; ++j) {
            const int tt = t - 3 + j;
            float x[8]; bool have = true;
            if (tt >= 0) { const v4u w = *(const GAS v4u*)(Z0 + (size_t)(r - 3 + j) * D + col);
                x[0] = bflo(w.x); x[1] = bfhi(w.x); x[2] = bflo(w.y); x[3] = bfhi(w.y); x[4] = bflo(w.z); x[5] = bfhi(w.z); x[6] = bflo(w.w); x[7] = bfhi(w.w); }
            else if (r >= NP) { const float* sp = sconv + (size_t)(bsm * 3 + (tt + 3)) * D + col; const f32x4 s0 = *(const GAS f32x4*)sp, s1 = *(const GAS f32x4*)(sp + 4);
                x[0] = s0[0]; x[1] = s0[1]; x[2] = s0[2]; x[3] = s0[3]; x[4] = s1[0]; x[5] = s1[1]; x[6] = s1[2]; x[7] = s1[3]; }
            else have = false;
            if (have) { const f32x4 w0 = *(const GAS f32x4*)(wc + (size_t)j * D + col), w1 = *(const GAS f32x4*)(wc + (size_t)j * D + col + 4);
                y[0] += w0[0] * x[0]; y[1] += w0[1] * x[1]; y[2] += w0[2] * x[2]; y[3] += w0[3] * x[3]; y[4] += w1[0] * x[4]; y[5] += w1[1] * x[5]; y[6] += w1[2] * x[6]; y[7] += w1[3] * x[7]; }
        }
        const float scl = col >= 1024 ? 0.0625f : 1.0f;
#pragma unroll
        for (int e = 0; e < 8; ++e) y[e] = y[e] * sigmf(y[e]) * scl;
        v4u o; o.x = pk2(y[0], y[1]); o.y = pk2(y[2], y[3]); o.z = pk2(y[4], y[5]); o.w = pk2(y[6], y[7]);
        bf16* dst = col < 1024 ? QC + (size_t)r * 1024 + col : KC + (size_t)r * 1024 + (col - 1024);
        *(GAS v4u*)dst = o;
    }
}
__device__ __forceinline__ bf16x8 ldfrag(const LAS bf16* base, int row0, int ld, int k0, int lane) { return *(const LAS bf16x8*)(base + (row0 + (lane & 15)) * ld + k0 + 8 * (lane >> 4)); }
__device__ __forceinline__ bf16x8 ldfrag_t(const LAS bf16* base, int k0, int ld, int c0, int lane) {
    const LAS bf16* p = base + (k0 + 8 * (lane >> 4)) * ld + c0 + (lane & 15); bf16x8 r;
#pragma unroll
    for (int j = 0; j < 8; ++j) r[j] = (short)p[j * ld];
    return r;
}
#define MFMA16(a, b, c) __builtin_amdgcn_mfma_f32_16x16x32_bf16((a), (b), (c), 0, 0, 0)

constexpr int GM_LD = 136, GM_X = 0, GM_W = 128 * GM_LD * 2, GM_F = 2 * 128 * GM_LD * 2;
__device__ __forceinline__ void gmlp_prompt_unit(Frame& F, const Args& a, int b, int n, int g) {
    const int tid = F.tid, lane = F.lane, wave = F.wave;
    LAS bf16* Xs = (LAS bf16*)(F.lds + GM_X); LAS bf16* Ws = (LAS bf16*)(F.lds + GM_W);
    LAS float* mu = (LAS float*)(F.lds + GM_F); LAS float* rs = mu + 128; LAS float* alpha = mu + 256; LAS float* beta = mu + 384;
    const bf16* Z3 = WSP(bf16, WS_Z) + (size_t)3 * M * D; const bf16* Z4 = WSP(bf16, WS_Z) + (size_t)4 * M * D; bf16* HB = WSP(bf16, WS_AB) + D;
    const float* STAT = WSP(float, WS_STAT);
    const size_t r0 = (size_t)b * SEQ + (size_t)n * 128;
    if (tid < 128) { const GAS f32x4* sp = (const GAS f32x4*)(STAT + (r0 + tid) * 64); float s1 = 0.f, s2 = 0.f;
#pragma unroll
        for (int i = 0; i < 16; ++i) { const f32x4 v = sp[i]; s1 += v[0] + v[2]; s2 += v[1] + v[3]; }
        const float m_ = s1 * (1.0f / D), var = fmaxf(s2 * (1.0f / D) - m_ * m_, 0.f); mu[tid] = m_; rs[tid] = 1.0f / sqrtf(var + EPS); }
    __syncthreads();
    { const int t = tid >> 2, q = tid & 3; const float* wrow = a.in[I_WSP] + ((size_t)(g * 128 + t)) * 128 + 32 * q; float al = 0.f, be = 0.f;
#pragma unroll
      for (int i = 0; i < 8; ++i) { const f32x4 w = *(const GAS f32x4*)(wrow + 4 * i); float wp[4];
#pragma unroll
          for (int e = 0; e < 4; ++e) { const int s = 32 * q + 4 * i + e; const float wv = (s <= t) ? w[e] : 0.f; wp[e] = bflo(f2bf(wv * rs[s])); al += wp[e] * mu[s]; be += wv; }
          v2u o; o.x = pk2(wp[0], wp[1]); o.y = pk2(wp[2], wp[3]); *(LAS v2u*)(Ws + t * GM_LD + 32 * q + 4 * i) = o; }
      al += __shfl_xor(al, 1); al += __shfl_xor(al, 2); be += __shfl_xor(be, 1); be += __shfl_xor(be, 2);
      if (q == 0) { alpha[t] = al; beta[t] = be; } }
    v4u xn[4];
#define GM_LDX(cs_) do { const int cb_ = g * 512 + (cs_) * 128; _Pragma("unroll") for (int i = 0; i < 4; ++i) { const int ch = tid + 512 * i, row = ch >> 4, cc = ch & 15; \
        xn[i] = *(const GAS v4u*)(Z4 + (r0 + row) * D + cb_ + cc * 8); } } while (0)
    GM_LDX(0);
    for (int cs = 0; cs < 4; ++cs) {
        const int cbase = g * 512 + cs * 128;
#pragma unroll
        for (int i = 0; i < 4; ++i) { const int ch = tid + 512 * i, row = ch >> 4, cc = ch & 15; *(LAS v4u*)(Xs + row * GM_LD + cc * 8) = xn[i]; }
        __syncthreads();
        if (cs + 1 < 4) GM_LDX(cs + 1);
        const int cg = cbase + 16 * wave + 4 * (lane >> 4);
        v2u uw[8]; float bs[8];
#pragma unroll
        for (int ti = 0; ti < 8; ++ti) { const int t = ti * 16 + (lane & 15); uw[ti] = *(const GAS v2u*)(Z3 + (r0 + t) * D + cg); bs[ti] = a.in[I_BSP][g * 128 + t]; }
        const f32x4 gl = *(const GAS f32x4*)(a.in[I_GLN] + cg), bl = *(const GAS f32x4*)(a.in[I_BLN] + cg);
        f32x4 acc[8];
#pragma unroll
        for (int ti = 0; ti < 8; ++ti) acc[ti] = (f32x4){0.f, 0.f, 0.f, 0.f};
#pragma unroll
        for (int ks = 0; ks < 4; ++ks) { const bf16x8 af = ldfrag_t(Xs, ks * 32, GM_LD, 16 * wave, lane);
#pragma unroll
            for (int ti = 0; ti < 8; ++ti) if (ks <= (ti >> 1)) { const bf16x8 bfr = ldfrag(Ws, ti * 16, GM_LD, ks * 32, lane); acc[ti] = MFMA16(af, bfr, acc[ti]); } }
#pragma unroll
        for (int ti = 0; ti < 8; ++ti) { const int t = ti * 16 + (lane & 15); const float al = alpha[t], be = beta[t];
            const f32x4 u = (f32x4){bflo(uw[ti].x), bfhi(uw[ti].x), bflo(uw[ti].y), bfhi(uw[ti].y)};
            const f32x4 o = (gl * (acc[ti] - al) + bl * be + bs[ti]) * u;
            v2u w; w.x = pk2(o[0], o[1]); w.y = pk2(o[2], o[3]); *(GAS v2u*)(HB + (r0 + t) * (2 * D) + cg) = w; }
        __syncthreads();
    }
#undef GM_LDX
}
__device__ __forceinline__ void gmlp_sample_items(Frame& F, const Args& a, int it0, int it1, int step) {
    const int lane = F.lane;
    const bf16* Z3 = WSP(bf16, WS_Z) + (size_t)3 * M * D; const bf16* Z4 = WSP(bf16, WS_Z) + (size_t)4 * M * D; bf16* HB = WSP(bf16, WS_AB) + D;
    const float* STAT = WSP(float, WS_STAT); float* VS = F.out + O_VS;
    for (int it = it0; it < it1; it += step) {
        const int b = it >> 2, g = it & 3, c = g * 512 + lane * 8;
        float gl[8], bl[8];
        { const f32x4 g0 = *(const GAS f32x4*)(a.in[I_GLN] + c), g1 = *(const GAS f32x4*)(a.in[I_GLN] + c + 4), b0 = *(const GAS f32x4*)(a.in[I_BLN] + c), b1 = *(const GAS f32x4*)(a.in[I_BLN] + c + 4);
#pragma unroll
          for (int e = 0; e < 4; ++e) { gl[e] = g0[e]; gl[4 + e] = g1[e]; bl[e] = b0[e]; bl[4 + e] = b1[e]; } }
        float vg[4][8];
#pragma unroll
        for (int t = 0; t < 4; ++t) { const size_t row = (size_t)NP + 4 * b + t;
            float s1 = lane < 32 ? STAT[(row * 32 + lane) * 2] : 0.f, s2 = lane < 32 ? STAT[(row * 32 + lane) * 2 + 1] : 0.f; s1 = wave_sum(s1); s2 = wave_sum(s2);
            const float m_ = s1 * (1.0f / D), var = fmaxf(s2 * (1.0f / D) - m_ * m_, 0.f), rs = 1.0f / sqrtf(var + EPS);
            const v4u w = *(const GAS v4u*)(Z4 + row * D + c); float x[8] = {bflo(w.x), bfhi(w.x), bflo(w.y), bfhi(w.y), bflo(w.z), bfhi(w.z), bflo(w.w), bfhi(w.w)};
#pragma unroll
            for (int e = 0; e < 8; ++e) vg[t][e] = (x[e] - m_) * rs * gl[e] + bl[e];
            float* vo = VS + ((size_t)(4 * b + t)) * D + c;
            *(GAS f32x4*)vo = (f32x4){vg[t][0], vg[t][1], vg[t][2], vg[t][3]}; *(GAS f32x4*)(vo + 4) = (f32x4){vg[t][4], vg[t][5], vg[t][6], vg[t][7]}; }
#pragma unroll
        for (int t = 0; t < 4; ++t) { const size_t row = (size_t)NP + 4 * b + t; float o[8]; const float bs = a.in[I_BSP][g * 128 + t];
#pragma unroll
            for (int e = 0; e < 8; ++e) o[e] = bs;
#pragma unroll
            for (int s = 0; s < 4; ++s) if (s <= t) { const float w = a.in[I_WSP][((size_t)(g * 128 + t)) * 128 + s];
#pragma unroll
                for (int e = 0; e < 8; ++e) o[e] += w * vg[s][e]; }
            const v4u uw = *(const GAS v4u*)(Z3 + row * D + c); const float u[8] = {bflo(uw.x), bfhi(uw.x), bflo(uw.y), bfhi(uw.y), bflo(uw.z), bfhi(uw.z), bflo(uw.w), bfhi(uw.w)};
            v4u w; w.x = pk2(o[0] * u[0], o[1] * u[1]); w.y = pk2(o[2] * u[2], o[3] * u[3]); w.z = pk2(o[4] * u[4], o[5] * u[5]); w.w = pk2(o[6] * u[6], o[7] * u[7]);
            *(GAS v4u*)(HB + row * (2 * D) + c) = w; }
    }
}

__device__ __forceinline__ void mlstm_scalar_table_wg(Frame& F, int bh) {
    const int lane = F.lane, wave = F.wave, b = bh >> 2, h = bh & 3;
    const float* GT = WSP(float, WS_GATES); float* SCT = WSP(float, WS_SCT) + (size_t)bh * 32 * 384;
    LAS float* B63 = (LAS float*)F.lds; LAS float* P63 = B63 + 32; LAS float* MC = B63 + 64; LAS float* M63 = B63 + 96;
    float as[4], pm[4], bc[4];
#pragma unroll
    for (int i = 0; i < 4; ++i) { const int c = 4 * wave + i; const size_t r = (size_t)b * SEQ + (size_t)c * 64 + lane;
        const float ig = GT[r * 8 + h], lf = GT[r * 8 + 4 + h];
        float s = lf;
#pragma unroll
        for (int o = 1; o < 64; o <<= 1) { const float t = __shfl_up(s, o); if (lane >= o) s += t; }
        bc[i] = s; as[i] = ig - s; float p = as[i];
#pragma unroll
        for (int o = 1; o < 64; o <<= 1) { const float t = __shfl_up(p, o); if (lane >= o) p = fmaxf(p, t); }
        pm[i] = p;
        if (lane == 63) { B63[c] = s; P63[c] = p; } }
    __syncthreads();
    if (F.tid == 0) { float m = 0.f;
        for (int c = 0; c < 32; ++c) { MC[c] = m; const float mm = fmaxf(m, P63[c]); M63[c] = mm; m = B63[c] + mm; } }
    __syncthreads();
#pragma unroll
    for (int i = 0; i < 4; ++i) { const int c = 4 * wave + i; float* sc = SCT + c * 384; const float m_c = MC[c], m63 = M63[c], Mt = fmaxf(m_c, pm[i]);
        const float Ac = P63[c];
        sc[lane] = __expf(as[i] - Ac); sc[64 + lane] = __expf(Ac - Mt); sc[128 + lane] = __expf(m_c - Mt); sc[192 + lane] = __expf(-(bc[i] + Mt)); sc[256 + lane] = __expf(as[i] - m63);
        if (lane == 0) { sc[320] = __expf(m_c - m63); sc[321] = B63[c] + m63; } }
    __syncthreads();
}
typedef short s16x4 __attribute__((ext_vector_type(4)));
constexpr int CH_LDQ = 272, CH_LDV = 144, CH_LDSS = 80;
constexpr int CH_Q = 0, CH_K = CH_Q + 64 * CH_LDQ * 2, CH_V = CH_K + 64 * CH_LDQ * 2, CH_WV = CH_V + 64 * CH_LDV * 2, CH_S = CH_WV + 64 * CH_LDV * 2, CH_N = CH_S + 64 * CH_LDSS * 2,
              CH_SC = CH_N + 2048, CH_QN = CH_SC + 2 * 384 * 4, CH_END = CH_QN + 256;
static_assert(CH_END <= LDS_PHASE_BYTES, "chain LDS");
__device__ __forceinline__ bf16x8 ldfrag_tr(const LAS bf16* base, int k0, int ld, int c0, int lane) {
    const int g = lane >> 4, q = (lane & 15) >> 2, p = lane & 3;
    const LAS bf16* a0 = base + (k0 + 8 * g + q) * ld + c0 + 4 * p;
    const s16x4 lo = __builtin_amdgcn_ds_read_tr16_b64_v4i16((LAS s16x4*)a0), hi = __builtin_amdgcn_ds_read_tr16_b64_v4i16((LAS s16x4*)(a0 + 4 * ld));
    return (bf16x8){lo[0], lo[1], lo[2], lo[3], hi[0], hi[1], hi[2], hi[3]};
}
#define CH_PIN2(a_, b_) asm volatile("" : "+v"(a_), "+v"(b_) :: "memory")
#define CH_PIN4(a_, b_, c_, d_) asm volatile("" : "+v"(a_), "+v"(b_), "+v"(c_), "+v"(d_) :: "memory")
#define CH_BAR() do { asm volatile("s_waitcnt lgkmcnt(0)" ::: "memory"); __builtin_amdgcn_s_barrier(); asm volatile("" ::: "memory"); } while (0)
__device__ __forceinline__ v4u pk8(f32x4 a, f32x4 b) { v4u w; w.x = pg8::cvt_pk_bf16(a[0], a[1]); w.y = pg8::cvt_pk_bf16(a[2], a[3]); w.z = pg8::cvt_pk_bf16(b[0], b[1]); w.w = pg8::cvt_pk_bf16(b[2], b[3]); return w; }
constexpr int SR_LD = 264;
__device__ __forceinline__ void sraw_item(Frame& F, const Args& a, int bh, int c) {
    const int tid = F.tid, lane = F.lane, wave = F.wave, b = bh >> 2, h = bh & 3, lq = lane >> 4, lc = lane & 15;
    LAS bf16* Qs = (LAS bf16*)F.lds; LAS bf16* Ks = Qs + 64 * SR_LD;
    const bf16* Z0 = WSP(bf16, WS_Z); bf16* QC = WSP(bf16, WS_QC); bf16* KC = WSP(bf16, WS_KC); bf16* SRAW = WSP(bf16, WS_SRAW) + (size_t)(bh * 32 + c) * 4096;
    const float* wc = a.in[I_WCONV]; const float* bc = a.in[I_BCONV];
    const size_t r0 = (size_t)b * SEQ + (size_t)c * 64;
    { const int cg = tid & 63, isk = cg >> 5, cl = (cg & 31) * 8, col = (isk ? 1024 : 0) + h * 256 + cl;
      float wj[4][8], bj[8];
      { const f32x4 b0 = *(const GAS f32x4*)(bc + col), b1 = *(const GAS f32x4*)(bc + col + 4);
#pragma unroll
        for (int e = 0; e < 4; ++e) { bj[e] = b0[e]; bj[4 + e] = b1[e]; }
#pragma unroll
        for (int j = 0; j < 4; ++j) { const f32x4 w0 = *(const GAS f32x4*)(wc + (size_t)j * D + col), w1 = *(const GAS f32x4*)(wc + (size_t)j * D + col + 4);
#pragma unroll
            for (int e = 0; e < 4; ++e) { wj[j][e] = w0[e]; wj[j][4 + e] = w1[e]; } } }
      const float scl = isk ? 0.0625f : 1.0f;
      v4u tw[8][4];
#pragma unroll
      for (int i = 0; i < 8; ++i) { const int row = (tid >> 6) + 8 * i, t = c * 64 + row;
#pragma unroll
          for (int j = 0; j < 4; ++j) { tw[i][j] = (v4u){0u, 0u, 0u, 0u}; if (t - 3 + j >= 0) tw[i][j] = *(const GAS v4u*)(Z0 + (r0 + row - 3 + j) * D + col); } }
      asm volatile("" ::: "memory");
#pragma unroll
      for (int i = 0; i < 8; ++i) { const int row = (tid >> 6) + 8 * i; float y[8];
#pragma unroll
          for (int e = 0; e < 8; ++e) y[e] = bj[e];
#pragma unroll
          for (int j = 0; j < 4; ++j) { const v4u w = tw[i][j];
                  const float x[8] = {bflo(w.x), bfhi(w.x), bflo(w.y), bfhi(w.y), bflo(w.z), bfhi(w.z), bflo(w.w), bfhi(w.w)};
#pragma unroll
                  for (int e = 0; e < 8; ++e) y[e] += wj[j][e] * x[e]; }
#pragma unroll
          for (int e = 0; e < 8; ++e) y[e] = y[e] * sigmf(y[e]) * scl;
          v4u o; o.x = pk2(y[0], y[1]); o.y = pk2(y[2], y[3]); o.z = pk2(y[4], y[5]); o.w = pk2(y[6], y[7]);
          if (isk) *(GAS v4u*)(KC + (r0 + row) * 1024 + h * 256 + cl) = o;
          else { bf16* qd = QC + (r0 + row) * 1024 + h * 256 + (cl & ~31) + ((cl & 15) >> 2) * 8 + ((cl >> 4) & 1) * 4;
              *(GAS v2u*)qd = (v2u){o.x, o.y}; *(GAS v2u*)(qd + 8) = (v2u){o.z, o.w}; }
          *(LAS v4u*)((isk ? Ks : Qs) + row * SR_LD + cl) = o; } }
    __syncthreads();
#pragma unroll
    for (int q = 0; q < 2; ++q) { const int tt = wave + 8 * q, si = tt >> 2, ti = tt & 3, s0 = si * 16, t0 = ti * 16;
        v2u o = (v2u){0u, 0u};
        if (si <= ti) { f32x4 acc = (f32x4){0.f, 0.f, 0.f, 0.f};
#pragma unroll
            for (int ks = 0; ks < 8; ++ks) acc = MFMA16(ldfrag(Ks, s0, SR_LD, ks * 32, lane), ldfrag(Qs, t0, SR_LD, ks * 32, lane), acc);
            const int t = t0 + lc;
#pragma unroll
            for (int j = 0; j < 4; ++j) { const int s = s0 + 4 * lq + j; if (s > t) acc[j] = 0.f; }
            o.x = pk2(acc[0], acc[1]); o.y = pk2(acc[2], acc[3]); }
        *(GAS v2u*)(SRAW + (t0 + lc) * 64 + s0 + 4 * lq) = o; }
    __syncthreads();
}
__device__ __forceinline__ bf16x8 scale8(bf16x8 v, f32x4 e0, f32x4 e1) {
    const v4u a = __builtin_bit_cast(v4u, v); v4u o;
    o.x = pg8::cvt_pk_bf16(bflo(a.x) * e0[0], bfhi(a.x) * e0[1]); o.y = pg8::cvt_pk_bf16(bflo(a.y) * e0[2], bfhi(a.y) * e0[3]);
    o.z = pg8::cvt_pk_bf16(bflo(a.z) * e1[0], bfhi(a.z) * e1[1]); o.w = pg8::cvt_pk_bf16(bflo(a.w) * e1[2], bfhi(a.w) * e1[3]);
    return __builtin_bit_cast(bf16x8, o);
}
constexpr int CH5_Q = 0, CH5_K = 65536, CH5_V = 131072, CH5_N = CH5_V + 16384, CH5_SC = CH5_N + 2048, CH5_NB = CH5_SC + 2 * 384 * 4, CH5_END = CH5_NB + 2 * 512;
static_assert(CH5_END <= LDS_PHASE_BYTES, "chain LDS");
__device__ __forceinline__ int ch_swz(int row) { return ((row & 3) << 1) | (((row >> 3) & 1) << 3); }
#define CH_TR(dst_, addr_, off_) asm volatile("ds_read_b64_tr_b16 %0, %1 offset:%2" : "=v"(dst_) : "v"(addr_), "n"(off_) : "memory")
#define CH_LGKM4(n_, a_, b_, c_, d_) asm volatile("s_waitcnt lgkmcnt(%4)" : "+v"(a_), "+v"(b_), "+v"(c_), "+v"(d_) : "n"(n_) : "memory")
__device__ __forceinline__ bf16x8 ch_cat(v2u lo, v2u hi) { return __builtin_bit_cast(bf16x8, (v4u){lo.x, lo.y, hi.x, hi.y}); }
__device__ __forceinline__ void mlstm_chain_unit(Frame& F, const Args& a, int bh, int slice) {
    const int tid = F.tid, lane = F.lane, wave = F.wave, wv = __builtin_amdgcn_readfirstlane(F.wave), b = bh >> 2, h = bh & 3, lq = lane >> 4, lc = lane & 15, dvc = 16 * wv;
    LAS unsigned char* L = F.lds;
    LAS float* NV = (LAS float*)(L + CH5_N); LAS float* SC = (LAS float*)(L + CH5_SC);
    const bf16* QC = WSP(bf16, WS_QC); const bf16* KC = WSP(bf16, WS_KC); const bf16* ZV = WSP(bf16, WS_Z) + (size_t)1 * M * D; bf16* HRAW = WSP(bf16, WS_HRAW);
    const float* SCT = WSP(float, WS_SCT) + (size_t)bh * 32 * 384; const bf16* SRAW = WSP(bf16, WS_SRAW) + (size_t)bh * 32 * 4096; float* DENINV = WSP(float, WS_DENINV);
    NV[tid] = 0.f;
    if (tid < 256) ((LAS unsigned*)(L + CH5_NB))[tid] = 0u;
    f32x4 cacc[16]; const f32x4 z4 = (f32x4){0.f, 0.f, 0.f, 0.f};
#pragma unroll
    for (int i = 0; i < 16; ++i) cacc[i] = z4;
    const size_t rowbase = (size_t)b * SEQ;
    unsigned goff0; { const int row = 8 * wave + (lane >> 5), pc = lane & 31; goff0 = (unsigned)(row * 2048 + ((pc ^ ch_swz(row)) * 16)); }
    const char* gq = (const char*)(QC + rowbase * 1024 + h * 256); const char* gk = (const char*)(KC + rowbase * 1024 + h * 256);
    unsigned gvoff0; { const int s = lane, row = ((s >> 5) << 4) | ((((s >> 1) & 7) >> 2) << 3) | (((s >> 4) & 1) << 2) | ((s >> 1) & 3); gvoff0 = (unsigned)(row * (D * 2) + (s & 1) * 16); }
    const char* gv = (const char*)(ZV + rowbase * D + h * 512 + slice * 128 + dvc);
    const int svoff = lc * 128 + lq * 16;
    v4u sreg[8];
#define CH_DMA_QK(c_) do { const size_t cb_ = (size_t)(c_) * (64 * 2048); const int bo_ = ((c_) & 1) * 32768 + wv * 4096; \
        _Pragma("unroll") for (int i = 0; i < 4; ++i) { \
            const unsigned go_ = goff0 ^ ((i & 1) << 6); \
            __builtin_amdgcn_global_load_lds((const unsigned*)(gq + cb_ + i * 4096 + go_), (LAS unsigned*)(L + CH5_Q + bo_ + i * 1024), 16, 0, 0); \
            __builtin_amdgcn_global_load_lds((const unsigned*)(gk + cb_ + i * 4096 + go_), (LAS unsigned*)(L + CH5_K + bo_ + i * 1024), 16, 0, 0); } } while (0)
#define CH_DMA_V(c_) do { const size_t cb_ = (size_t)(c_) * (64 * D * 2); _Pragma("unroll") for (int i = 0; i < 2; ++i) \
        __builtin_amdgcn_global_load_lds((const unsigned*)(gv + cb_ + (size_t)i * (32 * D * 2) + gvoff0), (LAS unsigned*)(L + CH5_V + wv * 2048 + i * 1024), 16, 0, 0); } while (0)
#define CH_LD_S(c_) do { const char* sb_ = (const char*)SRAW + (size_t)(c_) * 8192; \
        asm volatile("global_load_dwordx4 %0, %4, %5\n\tglobal_load_dwordx4 %1, %4, %5 offset:64\n\tglobal_load_dwordx4 %2, %4, %5 offset:2048\n\tglobal_load_dwordx4 %3, %4, %5 offset:2112" \
            : "=&v"(sreg[0]), "=&v"(sreg[1]), "=&v"(sreg[2]), "=&v"(sreg[3]) : "v"(svoff), "s"(sb_) : "memory"); \
        asm volatile("global_load_dwordx4 %0, %4, %5\n\tglobal_load_dwordx4 %1, %4, %5 offset:64\n\tglobal_load_dwordx4 %2, %4, %5 offset:2048\n\tglobal_load_dwordx4 %3, %4, %5 offset:2112" \
            : "=&v"(sreg[4]), "=&v"(sreg[5]), "=&v"(sreg[6]), "=&v"(sreg[7]) : "v"(svoff), "s"(sb_ + 4096) : "memory"); } while (0)
#define CH_LD_SC(c_) do { if (wv == 0) { _Pragma("unroll") for (int i = 0; i < 6; ++i) \
        __builtin_amdgcn_global_load_lds((const unsigned*)(SCT + (c_) * 384 + 64 * i + lane), (LAS unsigned*)(L + CH5_SC + ((c_) & 1) * 1536 + i * 256), 4, 0, 0); } } while (0)
    const int sw = ch_swz(lc), tg = lane >> 4, tq = (lane & 15) >> 2, tp = lane & 3;
    const unsigned qb0 = (unsigned)(CH5_Q + lc * 512 + (((sw & 12) | (lq ^ (sw & 2))) << 4));
    const unsigned kb0 = (unsigned)(CH5_K + (8 * tg + tq) * 512 + (tp >> 1) * 16 + (tp & 1) * 8 + ((tq | ((tg & 1) << 2)) << 5));
    const unsigned vb0 = (unsigned)(CH5_V + wv * 2048 + ((tg >> 1) * 32 + ((tg & 1) * 4 + tq) * 2 + (tp >> 1)) * 16 + (tp & 1) * 8);
    const unsigned lbase = (unsigned)(__UINTPTR_TYPE__)L, vaddr = lbase + vb0;
    CH_LD_S(0); CH_LD_SC(0); CH_DMA_QK(0); CH_DMA_V(0);
    asm volatile("s_waitcnt vmcnt(0)" ::: "memory");
    for (int c = 0; c < SEQ / 64; ++c) {
        CH_BAR();
        CH_LD_SC(c + 1); CH_DMA_QK(c + 1);
        LAS float* sc = SC + (c & 1) * 384;
        const LAS float* NVc = NV + (c & 1) * 256; LAS float* NVn = NV + ((c + 1) & 1) * 256;
        const size_t r0 = rowbase + (size_t)c * 64;
        const unsigned qbase = qb0 + (c & 1) * 32768, kbase = kb0 + (c & 1) * 32768;
        f32x4 nacc[4], nac2[4], qacc = z4;
#pragma unroll
        for (int ti = 0; ti < 4; ++ti) { nacc[ti] = z4; nac2[ti] = z4; }
        { v4u qw[8][4];
#define CH_LDQP(ks_) do { const unsigned qa_ = (qbase ^ (((ks_) & 3) << 6)) + ((ks_) >> 2) * 256; _Pragma("unroll") for (int ti = 0; ti < 4; ++ti) qw[ks_][ti] = *(const LAS v4u*)(L + qa_ + ti * 8192); } while (0)
          CH_LDQP(0);
#pragma unroll
          for (int ks = 0; ks < 8; ++ks) {
              if (ks + 1 < 8) CH_LDQP(ks + 1);
              const bf16x8 cf = __builtin_bit_cast(bf16x8, pk8(cacc[2 * ks], cacc[2 * ks + 1]));
              CH_PIN4(qw[ks][0], qw[ks][1], qw[ks][2], qw[ks][3]);
#pragma unroll
              for (int ti = 0; ti < 4; ++ti) nacc[ti] = MFMA16(cf, __builtin_bit_cast(bf16x8, qw[ks][ti]), nacc[ti]);
          }
#undef CH_LDQP
          { const int tq_ = wv & 3, kh_ = wv >> 2; v4u qf[4], nf[4];
#pragma unroll
            for (int k4 = 0; k4 < 4; ++k4) { qf[k4] = *(const LAS v4u*)(L + ((qbase ^ (k4 << 6)) + kh_ * 256 + tq_ * 8192)); nf[k4] = *(const LAS v4u*)(L + CH5_NB + (c & 1) * 512 + kh_ * 256 + k4 * 64 + lq * 16); }
#pragma unroll
            for (int k4 = 0; k4 < 4; ++k4) qacc = MFMA16(__builtin_bit_cast(bf16x8, nf[k4]), __builtin_bit_cast(bf16x8, qf[k4]), qacc); }
        }
        float rsum[4];
        asm volatile("s_waitcnt vmcnt(20)" ::: "memory");
        v2u vt0, vt1, vt2, vt3; CH_TR(vt0, vaddr, 0); CH_TR(vt1, vaddr, 256); CH_TR(vt2, vaddr, 1024); CH_TR(vt3, vaddr, 1280);
        CH_LGKM4(0, vt0, vt1, vt2, vt3);
        const bf16x8 vfk0 = ch_cat(vt0, vt1), vfk1 = ch_cat(vt2, vt3);
        CH_DMA_V(c + 1);
        {
          const f32x4 c0 = *(const LAS f32x4*)(sc + 8 * lq), c1 = *(const LAS f32x4*)(sc + 8 * lq + 4), c2 = *(const LAS f32x4*)(sc + 32 + 8 * lq), c3 = *(const LAS f32x4*)(sc + 32 + 8 * lq + 4);
          const bf16x8 vf0 = scale8(vfk0, c0, c1), vf1 = scale8(vfk1, c2, c3);
          const bf16x8 cb0 = __builtin_bit_cast(bf16x8, pk8(c0, c1)), cb1 = __builtin_bit_cast(bf16x8, pk8(c2, c3));
          asm volatile("s_waitcnt vmcnt(14)" : "+v"(sreg[0]), "+v"(sreg[1]), "+v"(sreg[2]), "+v"(sreg[3]), "+v"(sreg[4]), "+v"(sreg[5]), "+v"(sreg[6]), "+v"(sreg[7]) :: "memory");
#pragma unroll
          for (int ti = 0; ti < 4; ++ti) { const bf16x8 sa = __builtin_bit_cast(bf16x8, sreg[2 * ti]), sb = __builtin_bit_cast(bf16x8, sreg[2 * ti + 1]);
              nac2[ti] = MFMA16(vf0, sa, nac2[ti]); nac2[ti] = MFMA16(vf1, sb, nac2[ti]);
              f32x4 ra = MFMA16(cb0, sa, z4); ra = MFMA16(cb1, sb, ra); rsum[ti] = ra[0]; } }
        { const float decay = sc[320];
          const f32x4 e0 = *(const LAS f32x4*)(sc + 256 + 8 * lq), e1 = *(const LAS f32x4*)(sc + 256 + 8 * lq + 4), e2 = *(const LAS f32x4*)(sc + 288 + 8 * lq), e3 = *(const LAS f32x4*)(sc + 288 + 8 * lq + 4);
          const bf16x8 wf0 = scale8(vfk0, e0, e1), wf1 = scale8(vfk1, e2, e3);
          const bf16x8 ef0 = __builtin_bit_cast(bf16x8, pk8(e0, e1)), ef1 = __builtin_bit_cast(bf16x8, pk8(e2, e3));
          v2u kt[16][4];
#define CH_KTR(dt_) do { const unsigned ka_ = lbase + ((kbase ^ (((dt_) & 7) << 5)) + ((dt_) >> 3) * 256); CH_TR(kt[dt_][0], ka_, 0); CH_TR(kt[dt_][1], ka_, 2048); CH_TR(kt[dt_][2], ka_, 16384); CH_TR(kt[dt_][3], ka_, 18432); } while (0)
          CH_KTR(0); CH_KTR(1);
#pragma unroll
          for (int dt = 0; dt < 16; ++dt) { if (dt + 2 < 16) CH_KTR(dt + 2);
              if (dt < 14) CH_LGKM4(8, kt[dt][0], kt[dt][1], kt[dt][2], kt[dt][3]); else if (dt == 14) CH_LGKM4(4, kt[dt][0], kt[dt][1], kt[dt][2], kt[dt][3]); else CH_LGKM4(0, kt[dt][0], kt[dt][1], kt[dt][2], kt[dt][3]);
              const bf16x8 kf0 = ch_cat(kt[dt][0], kt[dt][1]), kf1 = ch_cat(kt[dt][2], kt[dt][3]);
              f32x4 acc = cacc[dt] * decay; acc = MFMA16(kf0, wf0, acc); acc = MFMA16(kf1, wf1, acc); cacc[dt] = acc;
              if ((dt >> 1) == wave) {
                  f32x4 na = MFMA16(kf0, ef0, z4); na = MFMA16(kf1, ef1, na);
                  if (lc == 0) { const f32x4 nn = *(const LAS f32x4*)(NVc + dt * 16 + 4 * lq) * decay + na; *(LAS f32x4*)(NVn + dt * 16 + 4 * lq) = nn;
                      v2u nb; nb.x = pg8::cvt_pk_bf16(nn[0], nn[1]); nb.y = pg8::cvt_pk_bf16(nn[2], nn[3]);
                      *(LAS v2u*)(L + CH5_NB + ((c + 1) & 1) * 512 + ((dt >> 1) * 32 + 8 * lq + 4 * (dt & 1)) * 2) = nb; } } }
#undef CH_KTR
        }
        asm volatile("" ::: "memory");
        CH_LD_S(c + 1);
        { bf16* hb_ = HRAW + r0 * D + h * 512 + slice * 128 + dvc; const unsigned hoff = (unsigned)(lc * D + 4 * lq);
#pragma unroll
          for (int ti = 0; ti < 4; ++ti) { const int t = ti * 16 + lc; const f32x4 o = nacc[ti] * sc[128 + t] + nac2[ti] * sc[64 + t];
              v2u w; w.x = pg8::cvt_pk_bf16(o[0], o[1]); w.y = pg8::cvt_pk_bf16(o[2], o[3]); *(GAS v2u*)(hb_ + ti * 16 * D + hoff) = w; }
          if (slice == 0 && lq == 0) { const int tq_ = wv & 3, t = tq_ * 16 + lc; float* dp = DENINV + ((r0 + t) * 4 + h) * 4;
              if (wv < 4) { const float rs_ = tq_ == 0 ? rsum[0] : (tq_ == 1 ? rsum[1] : (tq_ == 2 ? rsum[2] : rsum[3]));
                  *(GAS v2u*)dp = (v2u){__float_as_uint(sc[64 + t] * rs_ + sc[128 + t] * qacc[0]), __float_as_uint(sc[192 + t])}; }
              else dp[2] = sc[128 + t] * qacc[0]; } }
        asm volatile("s_waitcnt vmcnt(14)" ::: "memory");
    }
#undef CH_DMA_QK
#undef CH_DMA_V
#undef CH_LD_S
#undef CH_LD_SC
    asm volatile("s_waitcnt vmcnt(0)\n\ts_nop 0\n\ts_nop 0\n\ts_nop 0\n\ts_nop 0\n\ts_nop 0\n\ts_nop 0\n\ts_nop 0\n\ts_nop 0\n\ts_nop 0\n\ts_nop 0\n\ts_nop 0\n\ts_nop 0\n\ts_nop 0\n\ts_nop 0\n\ts_nop 0" : "+v"(sreg[0]), "+v"(sreg[1]), "+v"(sreg[2]), "+v"(sreg[3]), "+v"(sreg[4]), "+v"(sreg[5]), "+v"(sreg[6]), "+v"(sreg[7]) :: "memory");
    CH_BAR();
    int t2 = threadIdx.x; asm volatile("" : "+v"(t2));
    float* OC = F.out + O_CP + (size_t)bh * 256 * 512 + slice * 128 + dvc; float* ON = F.out + O_NP + (size_t)bh * 256;
    const unsigned ooff = (unsigned)((4 * ((t2 >> 4) & 3)) * 512 + (t2 & 15));
#pragma unroll
    for (int dt = 0; dt < 16; ++dt)
#pragma unroll
        for (int j = 0; j < 4; ++j) OC[(dt * 16 + j) * 512 + ooff] = cacc[dt][j];
    if (slice == 0 && t2 < 256) ON[t2] = NV[t2];
    if (slice == 0 && t2 == 0) F.out[O_MP + bh] = SCT[31 * 384 + 321];
    asm volatile("s_waitcnt vmcnt(0)" ::: "memory");
    __syncthreads();
}

constexpr int MS_Q = 0, MS_K = 1024, MS_KW = 2048, MS_V = 3072, MS_N = 5120, MS_SC = 5376, MS_SP = 5408, MS_QN = 5424, MS_RED = 5632, MS_END = MS_RED + 4 * 4 * 512;
static_assert(MS_END * 4 <= LDS_PHASE_BYTES, "sample mLSTM LDS");
__device__ __forceinline__ void mlstm_sample_unit(Frame& F, const Args& a, int b, int h) {
    const int tid = F.tid, lane = F.lane, wave = F.wave, bh = b * 4 + h;
    LAS float* L = (LAS float*)F.lds;
    const bf16* QC = WSP(bf16, WS_QC); const bf16* KC = WSP(bf16, WS_KC); const bf16* ZV = WSP(bf16, WS_Z) + (size_t)1 * M * D; const float* GT = WSP(float, WS_GATES); bf16* HRAW = WSP(bf16, WS_HRAW);
    const size_t r0 = (size_t)NP + 4 * b;
    { const int idx = tid * 2, row = idx >> 8, col = idx & 255;
      const unsigned qw = *(const GAS unsigned*)(QC + (r0 + row) * 1024 + h * 256 + col), kw = *(const GAS unsigned*)(KC + (r0 + row) * 1024 + h * 256 + col);
      L[MS_Q + idx] = bflo(qw); L[MS_Q + idx + 1] = bfhi(qw); L[MS_K + idx] = bflo(kw); L[MS_K + idx + 1] = bfhi(kw); }
    { const int idx = tid * 4, row = idx >> 9, col = idx & 511; const v2u vw = *(const GAS v2u*)(ZV + (r0 + row) * D + h * 512 + col);
      L[MS_V + idx] = bflo(vw.x); L[MS_V + idx + 1] = bfhi(vw.x); L[MS_V + idx + 2] = bflo(vw.y); L[MS_V + idx + 3] = bfhi(vw.y); }
    if (tid < 256) L[MS_N + tid] = a.in[I_SN][(size_t)bh * 256 + tid];
    if (tid < 16) L[MS_SP + tid] = 0.f;
    if (tid == 0) {
        const float m0 = a.in[I_SM][bh]; float bc = 0.f, pm = -INFINITY, as[4], Mt = m0;
#pragma unroll
        for (int t = 0; t < 4; ++t) { const float ig = GT[(r0 + t) * 8 + h], lf = GT[(r0 + t) * 8 + 4 + h]; bc += lf; as[t] = ig - bc; pm = fmaxf(pm, as[t]); Mt = fmaxf(m0, pm);
            L[MS_SC + t] = as[t]; L[MS_SC + 4 + t] = Mt; L[MS_SC + 8 + t] = __expf(m0 - Mt); L[MS_SC + 12 + t] = __expf(-(bc + Mt)); }
#pragma unroll
        for (int t = 0; t < 4; ++t) L[MS_SC + 16 + t] = __expf(as[t] - Mt);
        L[MS_SC + 20] = __expf(m0 - Mt); L[MS_SC + 21] = bc + Mt;
    }
    __syncthreads();
    for (int idx = wave; idx < 14; idx += NWAVES) {
        int t, s; const LAS float* y;
        if (idx < 10) { t = idx >= 6 ? 3 : (idx >= 3 ? 2 : (idx >= 1 ? 1 : 0)); s = idx - (t * (t + 1)) / 2; y = L + MS_K + s * 256; } else { t = idx - 10; s = 0; y = L + MS_N; }
        const LAS float* x = L + MS_Q + t * 256; float d = 0.f;
#pragma unroll
        for (int i = 0; i < 4; ++i) d += x[lane + 64 * i] * y[lane + 64 * i];
        d = wave_sum(d);
        if (lane == 0) { if (idx < 10) L[MS_SP + t * 4 + s] = d * __expf(L[MS_SC + s] - L[MS_SC + 4 + t]); else L[MS_QN + t] = d; }
    }
    { const int idx = tid * 2, s = idx >> 8; const float we = L[MS_SC + 16 + s]; L[MS_KW + idx] = L[MS_K + idx] * we; L[MS_KW + idx + 1] = L[MS_K + idx + 1] * we; }
    __syncthreads();
    const int rsub = tid >> 7, c4 = tid & 127; const float decay = L[MS_SC + 20];
    f32x4 vs[4], qc[4];
#pragma unroll
    for (int s = 0; s < 4; ++s) { vs[s] = *(const LAS f32x4*)(L + MS_V + s * 512 + 4 * c4); qc[s] = (f32x4){0.f, 0.f, 0.f, 0.f}; }
    const float* Cin = a.in[I_SC] + (size_t)bh * 256 * 512 + 4 * c4; float* Cout = F.out + O_CS + (size_t)bh * 256 * 512 + 4 * c4;
#pragma unroll 16
    for (int i = 0; i < 64; ++i) { const int d = 4 * i + rsub;
        const f32x4 c0 = __builtin_nontemporal_load((const f32x4*)(Cin + (size_t)d * 512));
        f32x4 cn = c0 * decay;
#pragma unroll
        for (int s = 0; s < 4; ++s) { cn += vs[s] * L[MS_KW + s * 256 + d]; qc[s] += c0 * L[MS_Q + s * 256 + d]; }
        __builtin_nontemporal_store(cn, (f32x4*)(Cout + (size_t)d * 512)); }
#pragma unroll
    for (int t = 0; t < 4; ++t) *(LAS f32x4*)(L + MS_RED + (rsub * 4 + t) * 512 + 4 * c4) = qc[t];
    __syncthreads();
    { const int t = rsub; f32x4 s = (f32x4){0.f, 0.f, 0.f, 0.f};
#pragma unroll
      for (int rs = 0; rs < 4; ++rs) s += *(const LAS f32x4*)(L + MS_RED + (rs * 4 + t) * 512 + 4 * c4);
      const float wp = L[MS_SC + 8 + t]; f32x4 num = s * wp; float den = wp * L[MS_QN + t];
#pragma unroll
      for (int s2 = 0; s2 < 4; ++s2) { const float sp = L[MS_SP + t * 4 + s2]; num += vs[s2] * sp; den += sp; }
      const float inv = 1.0f / fmaxf(fabsf(den), L[MS_SC + 12 + t]);
      const f32x4 o = num * inv; v2u w; w.x = pk2(o[0], o[1]); w.y = pk2(o[2], o[3]); *(GAS v2u*)(HRAW + (r0 + t) * D + h * 512 + 4 * c4) = w; }
    if (tid < 4) *(GAS f32x4*)(WSP(float, WS_DENINV) + ((r0 + tid) * 4 + h) * 4) = (f32x4){1.0f, 0.0f, 0.0f, 0.0f};
    if (tid < 256) { float nn = decay * L[MS_N + tid];
#pragma unroll
        for (int s = 0; s < 4; ++s) nn += L[MS_KW + s * 256 + tid];
        F.out[O_NS + (size_t)bh * 256 + tid] = nn; }
    if (tid == 0) F.out[O_MS + bh] = L[MS_SC + 21];
    __syncthreads();
}

__device__ __forceinline__ void headnorm_all(Frame& F, const Args& a) {
    const int gw = F.vcu * NWAVES + F.wave, NGW = F.G * NWAVES, lane = F.lane;
    const bf16* HRAW = WSP(bf16, WS_HRAW); const bf16* Z2 = WSP(bf16, WS_Z) + (size_t)2 * M * D; bf16* HA = WSP(bf16, WS_AB);
    f32x4 gh[8];
#pragma unroll
    for (int j = 0; j < 8; ++j) gh[j] = ((const GAS f32x4*)a.in[I_GHEAD])[lane + 64 * j];
    for (int r = gw; r < M; r += NGW) {
        const GAS v2u* hp = (const GAS v2u*)(HRAW + (size_t)r * D) + lane; f32x4 v[8]; float ss[4];
        f32x4 di;
#pragma unroll
        for (int hh = 0; hh < 4; ++hh) { const f32x4 x = *(const GAS f32x4*)(WSP(float, WS_DENINV) + ((size_t)r * 4 + hh) * 4); di[hh] = 1.0f / fmaxf(fabsf(x[0] + x[2]), x[1]); }
#pragma unroll
        for (int j = 0; j < 8; ++j) { const v2u hw = hp[64 * j]; v[j] = (f32x4){bflo(hw.x), bfhi(hw.x), bflo(hw.y), bfhi(hw.y)} * di[j >> 1]; }
#pragma unroll
        for (int hh = 0; hh < 4; ++hh) { ss[hh] = wave_sum(dot4(v[2 * hh], v[2 * hh]) + dot4(v[2 * hh + 1], v[2 * hh + 1])); ss[hh] = 1.0f / sqrtf(ss[hh] * (1.0f / 512.0f) + EPS); }
#pragma unroll
        for (int j = 0; j < 8; ++j) { const f32x4 g = gh[j]; const v2u ow = ((const GAS v2u*)(Z2 + (size_t)r * D))[lane + 64 * j];
            const f32x4 o = (f32x4){bflo(ow.x), bfhi(ow.x), bflo(ow.y), bfhi(ow.y)}; const f32x4 y = (v[j] * ss[j >> 1]) * g * o;
            v2u w; w.x = pk2(y[0], y[1]); w.y = pk2(y[2], y[3]); ((GAS v2u*)(HA + (size_t)r * (2 * D)))[lane + 64 * j] = w; }
    }
}

__device__ __forceinline__ void mixfix_all(Frame& F, int nslab) {
    const int gw = F.vcu * NWAVES + F.wave, NGW = F.G * NWAVES, lane = F.lane;
    bf16* MIX = WSP(bf16, WS_MIX);
    for (int r = gw; r < NS; r += NGW) {
        const GAS f32x4* sp = (const GAS f32x4*)(WSP(float, WS_SLAB) + (size_t)r * D) + lane; f32x4 t[8];
#pragma unroll
        for (int j = 0; j < 8; ++j) t[j] = sp[64 * j];
        _Pragma("unroll 4") for (int s = 1; s < nslab; ++s) { sp += (size_t)NS * D / 4;
#pragma unroll
            for (int j = 0; j < 8; ++j) t[j] += sp[64 * j]; }
#pragma unroll
        for (int j = 0; j < 8; ++j) { v2u w; w.x = pk2(t[j][0], t[j][1]); w.y = pk2(t[j][2], t[j][3]); ((GAS v2u*)(MIX + (size_t)(NP + r) * D))[lane + 64 * j] = w; }
    }
}

constexpr int AUX_CONV = (NITEMS_LATE + 31) / 32, AUX_TOTAL = 512 + 256 + 64 + AUX_CONV;
constexpr int IT_L0 = 4 * IT_SQ + IT_PU;
constexpr int AUX_TOTAL_256 = 512 + 256 + 64 + (IT_L0 - 2 * IT_SQ) / 32;
static_assert((IT_L0 - 2 * IT_SQ) % 32 == 0, "queue items");
__device__ __forceinline__ void aux_run(Frame& F, const Args& a, int item) {
    if (item < 512) mlstm_sample_unit(F, a, item >> 2, item & 3);
    else if (item < 768) { const int u = item - 512; gmlp_prompt_unit(F, a, u >> 6, (u >> 2) & 15, u & 3); }
    else if (item < 832) { const int it0 = (item - 768) * 8 + F.wave; gmlp_sample_items(F, a, it0, it0 + 1, 1); }
    else { LAS float* scr = (LAS float*)(F.lds + F.wave * 16384);
        const int base = (F.G == 256 ? 2 * IT_SQ : 0) + (item - 832) * 32 + F.wave * 4, lim = F.G == 256 ? IT_L0 : NITEMS_LATE;
        for (int i = 0; i < 4; ++i) if (base + i < lim) transpose_late(a, F, scr, base + i); }
}

__device__ __forceinline__ void relaunder(Frame& F) { int t = threadIdx.x; asm volatile("" : "+v"(t)); F.tid = t; F.lane = t & 63; }
__global__ void __launch_bounds__(NWAVES * 64, 2) fwd_kernel(Args args) {
    extern __shared__ __attribute__((aligned(16))) unsigned char lds[];
    Frame F;
    F.lds = (LAS unsigned char*)lds;
    F.MISC = (volatile LAS unsigned*)(F.lds + MISC_OFF);
    F.tid = threadIdx.x; F.lane = F.tid & 63; F.wave = __builtin_amdgcn_readfirstlane(F.tid >> 6);
    F.G = gridDim.x; { const int bx = blockIdx.x; F.vcu = (F.G % 8 == 0) ? (bx % 8) * (F.G / 8) + bx / 8 : bx; }
    F.ws = args.ws; F.out = args.out;
    if (F.tid < 64) ((LAS unsigned*)(F.lds + MISC_OFF))[F.tid] = 0u;
    __syncthreads();
#if MK_SINGLE
    XcdBarrier bar = xcd_barrier_post((unsigned*)(F.ws + WS_CTL) + CW_BAR, F.MISC + 8);
#define GRID_BAR() xcd_barrier(bar)
#else
#define GRID_BAR() do { } while (0)
#endif
    const int lo = args.ph_lo, hi = args.ph_hi;
#ifndef PH_MASK
#define PH_MASK 0x1FFFF
#endif
#define IN(k) ((((PH_MASK) >> (k)) & 1) && lo <= (k) && (k) < hi)
#ifndef PH_REP
#define PH_REP 0
#endif
#define NREP(k) (1 + (((PH_REP) >> (k)) & 1))
#define PHASE(k) if (IN(k)) for (int rep_ = (relaunder(F), 0); rep_ < NREP(k); ++rep_)
    const int BX = (int)blockIdx.x;
#if MK_SINGLE
#define SEAM(k) do { if (IN(k) && IN((k) + 1)) { if (lo < 0) cooperative_groups::this_grid().sync(); else GRID_BAR(); } } while (0)
#else
#define SEAM(k) do { } while (0)
#endif
    const Args& a = args;
    bf16* XN = WSP(bf16, WS_XN); bf16* HFF = WSP(bf16, WS_HFF); bf16* T32 = WSP(bf16, WS_T32);     bf16* H = WSP(bf16, WS_H);

    PHASE(0) { p0_prologue(F, a); } SEAM(0);
    PHASE(1) { pg8::Gemm g{XN, WSP(bf16, WS_W1), M, 2 * FF, D, D / 64}; pg8::StaticOrder S; S.init(M, 2 * FF, F.G, BX); pg8::EpiSwiGLU E{HFF, FF};
        pg8::gemm_phase<pg8::EpiSwiGLU, pg8::StaticOrder, true, true>(F.lds, g, S, E);
        relaunder(F); transpose_tail(F, a, BX, 216, 2 * IT_FG, IT_FD); } SEAM(1);

    PHASE(2) { { pg8::Gemm g{HFF, WSP(bf16, WS_W1D), NP, D, FF, FF / 64}; pg8::StaticOrder S; S.init(NP, D, F.G, BX); pg8::EpiT16 E{T32};
            pg8::gemm_phase<pg8::EpiT16, pg8::StaticOrder, true, true>(F.lds, g, S, E); }
        { pg8::Gemm g{HFF, WSP(bf16, WS_W1D), M, D, FF, 22}; pg8::SplitOrder S{BX, 4, 22, 0}; pg8::EpiSlab E{WSP(float, WS_SLAB), 22};
            pg8::gemm_phase<pg8::EpiSlab, pg8::SplitOrder, true, true>(F.lds, g, S, E); }
        relaunder(F); transpose_tail(F, a, BX, 64, 2 * IT_FG + IT_FD, IT_INA + IT_INB); } SEAM(2);

    PHASE(3) { rowwise<1, false, 1>(F, a, nullptr, T32, a.in[I_G1POST], 0.5f, a.in[I_GMIXPRE], H, XN, nullptr, 4); } SEAM(3);
    PHASE(4) { pg8::Gemm g{XN, WSP(bf16, WS_WIN), M, NZG, D, D / 64}; pg8::ZOrder S; S.s.init(M, NZG, F.G, BX); pg8::EpiZ E{WSP(bf16, WS_Z), WSP(float, WS_STAT), F.out + O_CONVP, F.out + O_CONVS, WSP(float, WS_GATES), a.in[I_BI], a.in[I_BF]};
        pg8::gemm_phase<pg8::EpiZ, pg8::ZOrder, true, true>(F.lds, g, S, E);
        relaunder(F); transpose_tail<true>(F, a, BX, 146, 0, 2 * IT_SQ); transpose_tail<true>(F, a, BX, 146, IT_L0, IT_FG); } SEAM(4);

    PHASE(5) { for (int u = F.vcu; u < 16; u += F.G) mlstm_scalar_table_wg(F, u);
        for (int u = F.vcu; u < 512; u += F.G) sraw_item(F, a, u >> 5, u & 31);
        conv_silu_all(F, a); } SEAM(5);
    PHASE(6) { for (int u = F.vcu; u < 64; u += F.G) mlstm_chain_unit(F, a, u >> 2, u & 3);
        relaunder(F);
        unsigned* qctr = (unsigned*)(F.ws + WS_CTL) + CW_QUEUE;
        for (;;) { relaunder(F);     if (F.tid == 0) F.MISC[16] = atomicAdd(qctr, 1u); __syncthreads(); const int item = (int)F.MISC[16]; __syncthreads(); if (item >= (F.G == 256 ? AUX_TOTAL_256 : AUX_TOTAL)) break; aux_run(F, a, item); } } SEAM(6);
    PHASE(7) { headnorm_all(F, a); } SEAM(7);
    PHASE(8) { { pg8::Gemm g{WSP(bf16, WS_AB), WSP(bf16, WS_WAB), NP, D, 2 * D, 2 * D / 64}; pg8::StaticOrder S; S.init(NP, D, F.G, BX);
            pg8::EpiMerge E{WSP(bf16, WS_Z) + (size_t)5 * M * D, WSP(bf16, WS_Z) + (size_t)6 * M * D, WSP(bf16, WS_MIX)};
            pg8::gemm_phase<pg8::EpiMerge, pg8::StaticOrder, true, true>(F.lds, g, S, E); }
        { pg8::Gemm g{WSP(bf16, WS_AB), WSP(bf16, WS_WAB), M, D, 2 * D, 8}; pg8::SplitOrder S{BX, 8, 8, 0};
            pg8::EpiMergeSlab E{WSP(bf16, WS_Z) + (size_t)5 * M * D, WSP(bf16, WS_Z) + (size_t)6 * M * D, WSP(float, WS_SLAB), 8};
            pg8::gemm_phase<pg8::EpiMergeSlab, pg8::SplitOrder, true, true>(F.lds, g, S, E); }
        relaunder(F); transpose_tail<true>(F, a, BX, 128, IT_L0 + IT_FG, IT_FG); } SEAM(8);
    PHASE(9) { mixfix_all(F, 8);
        if (F.G == 256) { unsigned* mixcnt = (unsigned*)(F.ws + WS_CTL) + CW_MIXCNT;
            asm volatile("s_waitcnt vmcnt(0)" ::: "memory"); __syncthreads();
            if (F.tid == 0) { __builtin_amdgcn_fence(__ATOMIC_RELEASE, "agent"); asm volatile("s_waitcnt vmcnt(0)" ::: "memory"); __hip_atomic_fetch_add(mixcnt, 1u, __ATOMIC_RELAXED, __HIP_MEMORY_SCOPE_AGENT); } }
        else { __syncthreads();
            pg8::Gemm g{WSP(bf16, WS_PB), WSP(bf16, WS_WPU), M, D, DPLE, DPLE / 64}; pg8::StaticOrder S; S.init(M, D, F.G, BX); pg8::EpiT16 E{WSP(bf16, WS_PUP)};
            pg8::gemm_phase<pg8::EpiT16, pg8::StaticOrder, true, true>(F.lds, g, S, E); } }
    if (F.G != 256) { SEAM(9); }
    PHASE(10) { { pg8::Gemm g{WSP(bf16, WS_MIX), WSP(bf16, WS_WO), NP, D, D, D / 64}; pg8::StaticOrder S; S.init(NP, D, F.G, BX); pg8::EpiT16 E{T32};
            pg8::gemm_phase<pg8::EpiT16, pg8::StaticOrder, true, true>(F.lds, g, S, E); }
        if (F.G == 256 && IN(9) && BX < 128) { unsigned* mixcnt = (unsigned*)(F.ws + WS_CTL) + CW_MIXCNT;
            if (F.tid == 0) { unsigned sp_ = 0; while (__hip_atomic_load(mixcnt, __ATOMIC_RELAXED, __HIP_MEMORY_SCOPE_AGENT) < (unsigned)F.G && ++sp_ < (1u << 22)) __builtin_amdgcn_s_sleep(1);
                __builtin_amdgcn_fence(__ATOMIC_ACQUIRE, "agent"); asm volatile("s_waitcnt vmcnt(0)" ::: "memory"); }
            __syncthreads(); }
        { pg8::Gemm g{WSP(bf16, WS_MIX), WSP(bf16, WS_WO), M, D, D, 4}; pg8::SplitOrder S{BX, 8, 4, 0}; pg8::EpiSlab E{WSP(float, WS_SLAB), 4};
            pg8::gemm_phase<pg8::EpiSlab, pg8::SplitOrder, true, true>(F.lds, g, S, E); } } SEAM(10);
    PHASE(11) { rowwise<1, false, 1>(F, a, H, T32, a.in[I_GMIXPOST], 1.0f, a.in[I_G2PRE], H, XN, nullptr, 8); } SEAM(11);
    PHASE(12) { pg8::Gemm g{XN, WSP(bf16, WS_W2), M, 2 * FF, D, D / 64}; pg8::StaticOrder S; S.init(M, 2 * FF, F.G, BX); pg8::EpiSwiGLU E{HFF, FF};
        pg8::gemm_phase<pg8::EpiSwiGLU, pg8::StaticOrder, true, true>(F.lds, g, S, E);
        relaunder(F); transpose_tail<true>(F, a, BX, 216, IT_L0 + 2 * IT_FG, IT_FD); } SEAM(12);
    PHASE(13) { { pg8::Gemm g{HFF, WSP(bf16, WS_W2D), NP, D, FF, FF / 64}; pg8::StaticOrder S; S.init(NP, D, F.G, BX); pg8::EpiT16 E{T32};
            pg8::gemm_phase<pg8::EpiT16, pg8::StaticOrder, true, true>(F.lds, g, S, E); }
        { pg8::Gemm g{HFF, WSP(bf16, WS_W2D), M, D, FF, 22}; pg8::SplitOrder S{BX, 4, 22, 0}; pg8::EpiSlab E{WSP(float, WS_SLAB), 22};
            pg8::gemm_phase<pg8::EpiSlab, pg8::SplitOrder, true, true>(F.lds, g, S, E); }
        if (F.G == 256 && BX >= 64) {
            pg8::Gemm g{WSP(bf16, WS_PB), WSP(bf16, WS_WPU), M, D, DPLE, DPLE / 64}; pg8::StaticOrder S; S.init(M, D, 192, BX - 64); pg8::EpiT16 E{WSP(bf16, WS_PUP)};
            pg8::gemm_phase<pg8::EpiT16, pg8::StaticOrder, true, true>(F.lds, g, S, E); } } SEAM(13);
    PHASE(14) { rowwise<1, false, 1>(F, a, H, T32, a.in[I_G2POST], 0.5f, a.in[I_GPLEPRE], H, XN, nullptr, 4);
 } SEAM(14);
    PHASE(15) { { pg8::Gemm g{XN, WSP(bf16, WS_WPG), NP, D, D, D / 64}; pg8::StaticOrder S; S.init(NP, D, F.G, BX); pg8::EpiPle16 E{WSP(bf16, WS_PUP), T32};
            pg8::gemm_phase<pg8::EpiPle16, pg8::StaticOrder, true, true>(F.lds, g, S, E); }
        { pg8::Gemm g{XN, WSP(bf16, WS_WPG), M, D, D, 4}; pg8::SplitOrder S{BX, 8, 4, 0}; pg8::EpiSlab E{WSP(float, WS_SLAB), 4};
            pg8::gemm_phase<pg8::EpiSlab, pg8::SplitOrder, true, true>(F.lds, g, S, E); } } SEAM(15);
    PHASE(16) { rowwise<2, false, 2>(F, a, H, T32, a.in[I_GPLEPOST], 1.0f, nullptr, nullptr, nullptr, F.out + O_Y, 8, WSP(bf16, WS_PUP)); }
#undef IN
#undef SEAM
}

extern "C" void kernel_launch(void* const* d_in, const int* in_sizes, int n_in, void* d_out, int out_size, void* d_ws, size_t ws_size, hipStream_t stream) {
    static int grid = 0;
    if (grid == 0) {
        if (n_in != N_IN || (size_t)out_size != O_END || ws_size < WS_END) { fprintf(stderr, "kernel_launch: unexpected sizes: n_in %d out %d ws %zu (need %d, %zu, >= %zu)\n", n_in, out_size, ws_size, (int)N_IN, (size_t)O_END, (size_t)WS_END); grid = -1; return; }
        int dev = 0, cus = 0, per_cu = 0;
        if (hipGetDevice(&dev) != hipSuccess || hipDeviceGetAttribute(&cus, hipDeviceAttributeMultiprocessorCount, dev) != hipSuccess) { grid = -1; return; }
        if (hipFuncSetAttribute((const void*)fwd_kernel, hipFuncAttributeMaxDynamicSharedMemorySize, LDS_BYTES) != hipSuccess) { fprintf(stderr, "kernel_launch: hipFuncSetAttribute failed\n"); grid = -1; return; }
        if (hipOccupancyMaxActiveBlocksPerMultiprocessor(&per_cu, (const void*)fwd_kernel, NWAVES * 64, LDS_BYTES) != hipSuccess || per_cu < 1) { fprintf(stderr, "kernel_launch: occupancy query says %d\n", per_cu); (void)hipGetLastError(); }
        grid = cus;
    }
    if (grid < 0) return;
    Args a{};
    for (int i = 0; i < N_IN; ++i) a.in[i] = (const float*)d_in[i];
    a.out = (float*)d_out; a.ws = (unsigned char*)d_ws;
    (void)hipMemsetAsync((char*)d_ws + WS_CTL, 0, CTL_ZERO_BYTES, stream);
#if MK_SINGLE
    a.ph_lo = 0; a.ph_hi = N_PHASES;
    void* kargs[] = {&a};
    hipError_t e = hipLaunchCooperativeKernel((const void*)fwd_kernel, dim3(grid), dim3(NWAVES * 64), kargs, LDS_BYTES, stream);
    if (e != hipSuccess) fprintf(stderr, "kernel_launch: cooperative launch failed: %s (grid %d)\n", hipGetErrorString(e), grid);
#else
    for (int p = 0; p < N_PHASES; ++p) { a.ph_lo = p; a.ph_hi = p + 1; hipLaunchKernelGGL(fwd_kernel, dim3(grid), dim3(NWAVES * 64), LDS_BYTES, stream, a); }
#endif
}
```
